# Optimizing an MI355X kernel written in HIP

```python
import math
import jax, jax.numpy as jnp
from jax import lax
import numpy as np

D_MODEL = 1024
BATCH = 8
SEQ = 4096
DEPTH = 1

MEM_LEN = 256
ATT_WIDTH = D_MODEL // 2
HEAD_DIM = 64
N_ATT_HEADS = ATT_WIDTH // HEAD_DIM
CONV_WIDTH = D_MODEL - ATT_WIDTH
CONV_K = 3
DILATED_PATTERNS = ((128, 1), (512, 4), (2048, 16))
N_MEM_HEADS = 4
MEM_HEAD_DIM = D_MODEL // N_MEM_HEADS
D_FF = 4 * D_MODEL
NORM_EPS = 1e-6
NEG_INF = -1e30
IN_COLS = 3 * ATT_WIDTH + 3 * CONV_WIDTH

kernel_name = "hybrid_dilated_attn_shortconv_block"


def rms_norm(x, g):
    xf = x.astype(jnp.float32)
    y = xf * lax.rsqrt(jnp.mean(xf * xf, axis=-1, keepdims=True) + NORM_EPS)
    return (y * g.astype(jnp.float32)).astype(x.dtype)


def dilated_window_attention(q, k, v, window, dilation):
    b, s, h, e = q.shape
    steps = window // dilation
    span = steps * dilation
    s_pad = -(-s // span) * span
    nb = s_pad // span
    pad = ((0, 0), (0, s_pad - s), (0, 0), (0, 0))

    def blocks(t):
        return jnp.pad(t, pad).reshape(b, nb, steps, dilation, h, e)

    def with_prev(t):
        prev = jnp.pad(t, ((0, 0), (1, 0), (0, 0), (0, 0), (0, 0), (0, 0)))[:, :-1]
        return jnp.concatenate([prev, t], axis=2)

    qb = blocks(q)
    kk = with_prev(blocks(k))
    vv = with_prev(blocks(v))
    scale = 1.0 / math.sqrt(e)
    scores = jnp.einsum('bnqrhe,bnkrhe->bnrhqk', qb, kk).astype(jnp.float32) * scale
    i = jnp.arange(steps)[:, None]
    j = jnp.arange(2 * steps)[None, :]
    band = (j >= i) & (j <= i + steps)
    has_prev = (jnp.arange(nb) > 0)[:, None, None]
    valid = band[None] & (has_prev | (j[None] >= steps))
    scores = jnp.where(valid[None, :, None, None], scores, NEG_INF)
    lse = jax.nn.logsumexp(scores, axis=-1)
    p = jnp.exp(scores - lse[..., None]).astype(v.dtype)
    o = jnp.einsum('bnrhqk,bnkrhe->bnqrhe', p, vv)
    o = o.reshape(b, s_pad, h, e)[:, :s]
    lse = jnp.transpose(lse, (0, 1, 4, 2, 3)).reshape(b, s_pad, h)[:, :s]
    return o, lse


def short_gated_conv(bg, cg, xc, conv_w):
    u = cg * xc
    up = jnp.pad(u, ((0, 0), (CONV_K - 1, 0), (0, 0)))
    s = u.shape[1]
    conv = sum(up[:, tap:tap + s] * conv_w[tap] for tap in range(CONV_K))
    return bg * conv


def hybrid_mixer(h, w_in, conv_w, g_attn_out, g_conv_out, w_out):
    b, s, _ = h.shape
    proj = h @ w_in
    q, k, v, bg, cg, xc = jnp.split(proj, 6, axis=-1)
    q = q.reshape(b, s, N_ATT_HEADS, HEAD_DIM)
    k = k.reshape(b, s, N_ATT_HEADS, HEAD_DIM)
    v = v.reshape(b, s, N_ATT_HEADS, HEAD_DIM)
    outs, lses = [], []
    for window, dilation in DILATED_PATTERNS:
        o, lse = dilated_window_attention(q, k, v, window, dilation)
        outs.append(o)
        lses.append(lse)
    mix_w = jax.nn.softmax(jnp.stack(lses, axis=0), axis=0)
    attn = jnp.einsum('pbsh,pbshe->bshe', mix_w, jnp.stack(outs, axis=0).astype(jnp.float32))
    attn = attn.astype(h.dtype).reshape(b, s, ATT_WIDTH)
    conv = short_gated_conv(bg, cg, xc, conv_w)
    merged = jnp.concatenate([rms_norm(attn, g_attn_out), rms_norm(conv, g_conv_out)], axis=-1)
    return merged @ w_out


def memory_cross_attention(h, mem_n, w_q_mem, w_kv_mem, w_o_mem):
    b, s, _ = h.shape
    q = (h @ w_q_mem).reshape(b, s, N_MEM_HEADS, MEM_HEAD_DIM)
    kv = mem_n @ w_kv_mem
    k, v = jnp.split(kv, 2, axis=-1)
    k = k.reshape(b, MEM_LEN, N_MEM_HEADS, MEM_HEAD_DIM)
    v = v.reshape(b, MEM_LEN, N_MEM_HEADS, MEM_HEAD_DIM)
    scores = jnp.einsum('bshe,bmhe->bhsm', q, k).astype(jnp.float32) / math.sqrt(MEM_HEAD_DIM)
    p = jax.nn.softmax(scores, axis=-1).astype(v.dtype)
    o = jnp.einsum('bhsm,bmhe->bshe', p, v).reshape(b, s, D_MODEL)
    return o @ w_o_mem


def squared_relu_mlp(h, w_up, w_down):
    a = jax.nn.relu(h @ w_up)
    return (a * a) @ w_down


def setup_inputs(seed: int = 0) -> dict:
    key = jax.random.key(seed)
    ks = jax.random.split(key, 17)
    f32 = jnp.float32

    def dense(k, fan_in, shape, gain=1.0):
        return jax.random.normal(k, shape, f32) * (gain * fan_in ** -0.5)

    def gain(k, n):
        return 1.0 + 0.02 * jax.random.normal(k, (n,), f32)

    return {
        "x": jax.random.normal(ks[0], (BATCH, SEQ, D_MODEL), f32),
        "mem": jax.random.normal(ks[1], (BATCH, MEM_LEN, D_MODEL), f32),
        "g_mix": gain(ks[2], D_MODEL),
        "w_in": dense(ks[3], D_MODEL, (D_MODEL, IN_COLS)),
        "conv_w": dense(ks[4], CONV_K, (CONV_K, CONV_WIDTH)),
        "g_attn_out": gain(ks[5], ATT_WIDTH),
        "g_conv_out": gain(ks[6], CONV_WIDTH),
        "w_out": dense(ks[7], D_MODEL, (D_MODEL, D_MODEL), 0.5),
        "g_xattn": gain(ks[8], D_MODEL),
        "g_mem": gain(ks[9], D_MODEL),
        "w_q_mem": dense(ks[10], D_MODEL, (D_MODEL, D_MODEL)),
        "w_kv_mem": dense(ks[11], D_MODEL, (D_MODEL, 2 * D_MODEL)),
        "w_o_mem": dense(ks[12], D_MODEL, (D_MODEL, D_MODEL), 0.5),
        "g_mlp": gain(ks[13], D_MODEL),
        "w_up": dense(ks[14], D_MODEL, (D_MODEL, D_FF)),
        "w_down": dense(ks[15], D_FF, (D_FF, D_MODEL), 0.5),
        "g_final": gain(ks[16], D_MODEL),
    }


def reference(x, mem, g_mix, w_in, conv_w, g_attn_out, g_conv_out, w_out,
              g_xattn, g_mem, w_q_mem, w_kv_mem, w_o_mem,
              g_mlp, w_up, w_down, g_final):
    for _ in range(DEPTH):
        x = x + hybrid_mixer(rms_norm(x, g_mix), w_in, conv_w, g_attn_out, g_conv_out, w_out)
        x = x + memory_cross_attention(rms_norm(x, g_xattn), rms_norm(mem, g_mem),
                                       w_q_mem, w_kv_mem, w_o_mem)
        x = x + squared_relu_mlp(rms_norm(x, g_mlp), w_up, w_down)
    return rms_norm(x, g_final)
```

```cpp
#include <hip/hip_runtime.h>
#include <hip/hip_cooperative_groups.h>
#include <cstdio>
#include <cstdint>
namespace cg = cooperative_groups;

#ifndef N_LAUNCHES
#define N_LAUNCHES 1
#endif

namespace pg8 {
#define PG8_LAS __attribute__((address_space(3)))
typedef unsigned short bf16_t;
typedef short bf16x8 __attribute__((ext_vector_type(8)));
typedef float f32x4 __attribute__((ext_vector_type(4)));
typedef unsigned u32x4 __attribute__((ext_vector_type(4)));
constexpr int BM = 256, BK = 64, HALF = 128, HTB = HALF * BK * 2  , STAGE_BYTES = 8 * HTB, NXCD = 8, WGM = 8;

__host__ __device__ __forceinline__ int lds_byte(int r, int c) { const int st = (r >> 4) * 2 + (c >> 5), rr = r & 15, cc = c & 31, ob = rr * 64 + cc * 2; return st * 1024 + (ob ^ (((ob >> 9) & 1) << 5)); }
__host__ __device__ __forceinline__ void stage_rc(int b, int& R, int& C) { const int st = b / 1024, sb = b % 1024, swz = sb ^ (((sb >> 9) & 1) << 5); R = (st >> 1) * 16 + swz / 64; C = (st & 1) * 32 + (swz % 64) / 2; }
__host__ __device__ __forceinline__ int perm32(int rho) { const int n = rho >> 4, i = rho & 15; return 8 * (i >> 2) + 4 * n + (i & 3); }

struct Unit { int pm, pn; const char* a; const char* b; };
struct Gemm { int K, lda, ldb; };

struct StaticOrder {
    int nM, nN, nwg, G, c;
    __host__ __device__ void init(int M, int N, int G_, int c_) { nM = M / BM; nN = N / BM; nwg = nM * nN; G = G_; c = c_; }
    __host__ __device__ bool next(int i, Unit& u) const {
        const long L = (long)i * G + c; if (L >= nwg) return false;
        int wgid = (int)L; { const int q = nwg / NXCD, r = nwg % NXCD, xcd = wgid % NXCD, off = wgid / NXCD; wgid = (xcd < r ? xcd * (q + 1) : r * (q + 1) + (xcd - r) * q) + off; }
        const int nig = WGM * nN, gid = wgid / nig, fm = gid * WGM, gsz = (nM - fm) < WGM ? (nM - fm) : WGM;
        u.pm = fm + ((wgid % nig) % gsz); u.pn = (wgid % nig) / gsz; return true;
    }
};
__device__ __forceinline__ unsigned cvt_pk_bf16(float lo, float hi) { unsigned r; asm volatile("v_cvt_pk_bf16_f32 %0, %1, %2" : "=v"(r) : "v"(lo), "v"(hi)); return r; }

__device__ __forceinline__ u32x4 pack8(f32x4 v0, f32x4 v1) { u32x4 w; w.x = cvt_pk_bf16(v0[0], v0[1]); w.y = cvt_pk_bf16(v0[2], v0[3]); w.z = cvt_pk_bf16(v1[0], v1[1]); w.w = cvt_pk_bf16(v1[2], v1[3]); return w; }
__device__ __forceinline__ float sum16(const float* sp) { const f32x4 a = *(const f32x4*)sp, b = *(const f32x4*)(sp + 4), c = *(const f32x4*)(sp + 8), d = *(const f32x4*)(sp + 12);
    return ((a[0] + a[1]) + (a[2] + a[3])) + ((b[0] + b[1]) + (b[2] + b[3])) + ((c[0] + c[1]) + (c[2] + c[3])) + ((d[0] + d[1]) + (d[2] + d[3])); }

__device__ __forceinline__ void row_scales(const float* SS, int row0, int fq, float (&rs)[2][4]) {
    f32x4 t[2][4];
#pragma unroll
    for (int ai = 0; ai < 2; ++ai)
#pragma unroll
        for (int m = 0; m < 4; ++m) t[ai][m] = *(const f32x4*)(SS + (size_t)(row0 + ai * HALF + m * 16) * 16 + fq * 4);
#pragma unroll
    for (int ai = 0; ai < 2; ++ai)
#pragma unroll
        for (int m = 0; m < 4; ++m) { float s = (t[ai][m][0] + t[ai][m][1]) + (t[ai][m][2] + t[ai][m][3]); s += __shfl_xor(s, 16); s += __shfl_xor(s, 32); rs[ai][m] = __builtin_amdgcn_rsqf(s * (1.0f / 1024.0f) + 1e-6f); }
}
struct EpiStore {
    static constexpr bool PERM = true, AFTER_DRAIN = false;
    bf16_t* O; int ldc; int npn_scaled; float scale0;
    __device__ __forceinline__ void operator()(f32x4 (&acc)[2][2][4][2], const Unit& u, int wr, int wc, int fr, int fq) const {
        const int row0 = u.pm * BM + wr * 64 + fr, col0 = u.pn * BM + wc * 32 + 8 * fq;
        const float sc = (u.pn < npn_scaled) ? scale0 : 1.0f;
#pragma unroll
        for (int ai = 0; ai < 2; ++ai)
#pragma unroll
            for (int m = 0; m < 4; ++m) { bf16_t* rowp = O + (size_t)(row0 + ai * HALF + m * 16) * ldc + col0;
#pragma unroll
                for (int bj = 0; bj < 2; ++bj) *(u32x4*)(rowp + bj * HALF) = pack8(acc[ai][bj][m][0] * sc, acc[ai][bj][m][1] * sc); }
    }
};
struct EpiProj {
    static constexpr bool PERM = true, AFTER_DRAIN = false;
    bf16_t* PC; bf16_t* QKV; float scale0;
    __device__ __forceinline__ void operator()(f32x4 (&acc)[2][2][4][2], const Unit& u, int wr, int wc, int fr, int fq) const {
        const int row0 = u.pm * BM + wr * 64 + fr;
        if (u.pn >= 6) {
            const int col0 = (u.pn - 6) * BM + wc * 32 + 8 * fq;
#pragma unroll
            for (int ai = 0; ai < 2; ++ai)
#pragma unroll
                for (int m = 0; m < 4; ++m) { bf16_t* rowp = PC + (size_t)(row0 + ai * HALF + m * 16) * 1536 + col0;
#pragma unroll
                    for (int bj = 0; bj < 2; ++bj) *(u32x4*)(rowp + bj * HALF) = pack8(acc[ai][bj][m][0], acc[ai][bj][m][1]); }
        } else {
            const float sc = (u.pn < 2) ? scale0 : 1.0f;
            const int which = u.pn >> 1, d = (wc & 1) * 32 + 8 * fq;
            bf16_t* base = QKV + (size_t)which * 32768 * 512 + d;
#pragma unroll
            for (int ai = 0; ai < 2; ++ai)
#pragma unroll
                for (int m = 0; m < 4; ++m) { const int row = row0 + ai * HALF + m * 16;
#pragma unroll
                    for (int bj = 0; bj < 2; ++bj) { const int h = 4 * (u.pn & 1) + 2 * bj + (wc >> 1);
                        *(u32x4*)(base + ((size_t)((row >> 12) * 8 + h) * 4096 + (row & 4095)) * 64) = pack8(acc[ai][bj][m][0] * sc, acc[ai][bj][m][1] * sc); } }
        }
    }
};
template <bool BASE_BF16> struct EpiResid {
    static constexpr bool PERM = true, AFTER_DRAIN = false;
    const void* base; float* out; bf16_t* xb; float* SS;
    __device__ __forceinline__ void operator()(f32x4 (&acc)[2][2][4][2], const Unit& u, int wr, int wc, int fr, int fq) const {
        const int row0 = u.pm * BM + wr * 64 + fr, col0 = u.pn * BM + wc * 32 + 8 * fq;
#pragma unroll
        for (int ai = 0; ai < 2; ++ai) {
            u32x4 wb[4][2]; f32x4 fb[4][2][2];
#pragma unroll
            for (int m = 0; m < 4; ++m)
#pragma unroll
                for (int bj = 0; bj < 2; ++bj) { const size_t off = (size_t)(row0 + ai * HALF + m * 16) * 1024 + col0 + bj * HALF;
                    if (BASE_BF16) wb[m][bj] = *(const u32x4*)((const bf16_t*)base + off);
                    else { fb[m][bj][0] = *(const f32x4*)((const float*)base + off); fb[m][bj][1] = *(const f32x4*)((const float*)base + off + 4); } }
#pragma unroll
            for (int m = 0; m < 4; ++m) { const int row = row0 + ai * HALF + m * 16; float ss = 0.f;
#pragma unroll
                for (int bj = 0; bj < 2; ++bj) { const size_t off = (size_t)row * 1024 + col0 + bj * HALF;
                    f32x4 b0, b1;
                    if (BASE_BF16) { const u32x4 w = wb[m][bj];
                        b0 = (f32x4){__uint_as_float(w.x << 16), __uint_as_float(w.x & 0xffff0000u), __uint_as_float(w.y << 16), __uint_as_float(w.y & 0xffff0000u)};
                        b1 = (f32x4){__uint_as_float(w.z << 16), __uint_as_float(w.z & 0xffff0000u), __uint_as_float(w.w << 16), __uint_as_float(w.w & 0xffff0000u)}; }
                    else { b0 = fb[m][bj][0]; b1 = fb[m][bj][1]; }
                    const f32x4 v0 = acc[ai][bj][m][0] + b0, v1 = acc[ai][bj][m][1] + b1;
                    if (out) { *(f32x4*)(out + off) = v0; *(f32x4*)(out + off + 4) = v1; }
                    if (xb) *(u32x4*)(xb + off) = pack8(v0, v1);
                    ss += ((v0[0] * v0[0] + v0[1] * v0[1]) + (v0[2] * v0[2] + v0[3] * v0[3])) + ((v1[0] * v1[0] + v1[1] * v1[1]) + (v1[2] * v1[2] + v1[3] * v1[3])); }
                if (SS) { ss += __shfl_xor(ss, 16); ss += __shfl_xor(ss, 32); if (fq == 0) SS[(size_t)row * 16 + u.pn * 4 + wc] = ss; } }
            asm volatile("" ::: "memory");
        }
    }
};
struct EpiRelu2 {
    static constexpr bool PERM = true, AFTER_DRAIN = false;
    const float* SS; bf16_t* O; int ldo;
    __device__ __forceinline__ void operator()(f32x4 (&acc)[2][2][4][2], const Unit& u, int wr, int wc, int fr, int fq) const {
        const int row0 = u.pm * BM + wr * 64 + fr, col0 = u.pn * BM + wc * 32 + 8 * fq;
        float rsv[2][4]; row_scales(SS, row0, fq, rsv);
#pragma unroll
        for (int ai = 0; ai < 2; ++ai)
#pragma unroll
            for (int m = 0; m < 4; ++m) { const int row = row0 + ai * HALF + m * 16;
                const float rs = rsv[ai][m];
                bf16_t* rowp = O + (size_t)row * ldo + col0;
#pragma unroll
                for (int bj = 0; bj < 2; ++bj) { f32x4 v0 = acc[ai][bj][m][0] * rs, v1 = acc[ai][bj][m][1] * rs;
#pragma unroll
                    for (int e = 0; e < 4; ++e) { const float a = fmaxf(v0[e], 0.f), b = fmaxf(v1[e], 0.f); v0[e] = a * a; v1[e] = b * b; }
                    __builtin_nontemporal_store(pack8(v0, v1), (u32x4*)(rowp + bj * HALF)); } }
    }
};
struct EpiSoftmax {
    static constexpr bool PERM = true, AFTER_DRAIN = false;
    const float* SS; bf16_t* P; PG8_LAS float* xch;
    __device__ __forceinline__ void operator()(f32x4 (&acc)[2][2][4][2], const Unit& u, int wr, int wc, int fr, int fq) const {
        const int row0 = u.pm * BM + wr * 64 + fr, col0 = u.pn * BM + wc * 32 + 8 * fq;
        float mw[2][4];
        float rsv[2][4]; row_scales(SS, row0, fq, rsv);
#pragma unroll
        for (int ai = 0; ai < 2; ++ai)
#pragma unroll
            for (int m = 0; m < 4; ++m) { const int rl = ai * HALF + wr * 64 + m * 16 + fr;
                const float sc = rsv[ai][m] * (0.0625f * 1.4426950408889634f);
                float mx = -3.0e38f;
#pragma unroll
                for (int bj = 0; bj < 2; ++bj)
#pragma unroll
                    for (int n = 0; n < 2; ++n) { f32x4 v = acc[ai][bj][m][n] * sc; acc[ai][bj][m][n] = v; mx = fmaxf(mx, fmaxf(fmaxf(v[0], v[1]), fmaxf(v[2], v[3]))); }
                mx = fmaxf(mx, __shfl_xor(mx, 16)); mx = fmaxf(mx, __shfl_xor(mx, 32));
                float l = 0.f;
#pragma unroll
                for (int bj = 0; bj < 2; ++bj)
#pragma unroll
                    for (int n = 0; n < 2; ++n) { f32x4 v = acc[ai][bj][m][n];
#pragma unroll
                        for (int e = 0; e < 4; ++e) { v[e] = __builtin_amdgcn_exp2f(v[e] - mx); l += v[e]; }
                        acc[ai][bj][m][n] = v; }
                l += __shfl_xor(l, 16); l += __shfl_xor(l, 32);
                mw[ai][m] = mx;
                if (fq == 0) { xch[rl * 8 + wc * 2] = mx; xch[rl * 8 + wc * 2 + 1] = l; } }
        asm volatile("s_waitcnt lgkmcnt(0)\n\ts_barrier" ::: "memory");
#pragma unroll
        for (int ai = 0; ai < 2; ++ai)
#pragma unroll
            for (int m = 0; m < 4; ++m) { const int row = row0 + ai * HALF + m * 16; const int rl = ai * HALF + wr * 64 + m * 16 + fr;
                const f32x4 x0 = *(const PG8_LAS f32x4*)(xch + rl * 8), x1 = *(const PG8_LAS f32x4*)(xch + rl * 8 + 4);
                const float M = fmaxf(fmaxf(x0[0], x0[2]), fmaxf(x1[0], x1[2]));
                const float L = (x0[1] * __builtin_amdgcn_exp2f(x0[0] - M) + x0[3] * __builtin_amdgcn_exp2f(x0[2] - M)) + (x1[1] * __builtin_amdgcn_exp2f(x1[0] - M) + x1[3] * __builtin_amdgcn_exp2f(x1[2] - M));
                const float fac = __builtin_amdgcn_exp2f(mw[ai][m] - M) * __builtin_amdgcn_rcpf(L);
                bf16_t* rowp = P + (size_t)row * 1024 + col0;
#pragma unroll
                for (int bj = 0; bj < 2; ++bj) *(u32x4*)(rowp + bj * HALF) = pack8(acc[ai][bj][m][0] * fac, acc[ai][bj][m][1] * fac); }
        asm volatile("s_waitcnt lgkmcnt(0)" ::: "memory");
    }
};

struct EpiFinal {
    static constexpr bool PERM = true, AFTER_DRAIN = false;
    const bf16_t* base; float* out; const float* gain; unsigned* slots; unsigned* cnt; PG8_LAS float* tab;
    __device__ __forceinline__ void operator()(f32x4 (&acc)[2][2][4][2], const Unit& u, int wr, int wc, int fr, int fq) const {
        const int row0 = u.pm * BM + wr * 64 + fr, col0 = u.pn * BM + wc * 32 + 8 * fq;
        const int lane = fr + 16 * fq, wid = wr * 4 + wc;
        PG8_LAS float* Ptab = tab; PG8_LAS float* Stab = tab + 1024;
#pragma unroll
        for (int ai = 0; ai < 2; ++ai)
#pragma unroll
            for (int m = 0; m < 4; ++m) { const int row = row0 + ai * HALF + m * 16; float ss = 0.f;
#pragma unroll
                for (int bj = 0; bj < 2; ++bj) { const size_t off = (size_t)row * 1024 + col0 + bj * HALF;
                    const u32x4 w = *(const u32x4*)(base + off);
                    const f32x4 b0 = (f32x4){__uint_as_float(w.x << 16), __uint_as_float(w.x & 0xffff0000u), __uint_as_float(w.y << 16), __uint_as_float(w.y & 0xffff0000u)};
                    const f32x4 b1 = (f32x4){__uint_as_float(w.z << 16), __uint_as_float(w.z & 0xffff0000u), __uint_as_float(w.w << 16), __uint_as_float(w.w & 0xffff0000u)};
                    const f32x4 v0 = acc[ai][bj][m][0] + b0, v1 = acc[ai][bj][m][1] + b1; acc[ai][bj][m][0] = v0; acc[ai][bj][m][1] = v1;
                    ss += ((v0[0] * v0[0] + v0[1] * v0[1]) + (v0[2] * v0[2] + v0[3] * v0[3])) + ((v1[0] * v1[0] + v1[1] * v1[1]) + (v1[2] * v1[2] + v1[3] * v1[3])); }
                ss += __shfl_xor(ss, 16); ss += __shfl_xor(ss, 32);
                if (fq == 0) Ptab[(ai * HALF + wr * 64 + m * 16 + fr) * 4 + wc] = ss; }
        asm volatile("s_waitcnt lgkmcnt(0)\n\ts_barrier" ::: "memory");
        const int rowl = wid * 32 + (lane & 31);
        if (lane < 32) { const f32x4 p = *(const PG8_LAS f32x4*)(Ptab + rowl * 4);
            __hip_atomic_store(slots + ((size_t)(u.pm * BM + rowl) * 4 + u.pn), __float_as_uint((p[0] + p[1]) + (p[2] + p[3])), __ATOMIC_RELAXED, __HIP_MEMORY_SCOPE_AGENT); }
        asm volatile("s_waitcnt vmcnt(0)" ::: "memory");
        if (lane == 0) __hip_atomic_fetch_add(cnt + 64 * u.pm, 1u, __ATOMIC_RELAXED, __HIP_MEMORY_SCOPE_AGENT);
        if (wid == 0) {
            unsigned sp = 0;
            while ((unsigned)__builtin_amdgcn_readfirstlane(__hip_atomic_load(cnt + 64 * u.pm, __ATOMIC_RELAXED, __HIP_MEMORY_SCOPE_AGENT)) < 32u) { __builtin_amdgcn_s_sleep(2); if (++sp > (1u << 22)) break; }
            __builtin_amdgcn_fence(__ATOMIC_ACQUIRE, "agent");
        }
        asm volatile("s_waitcnt vmcnt(0) lgkmcnt(0)\n\ts_barrier" ::: "memory");
        if (lane < 32) { const unsigned* sl = slots + (size_t)(u.pm * BM + rowl) * 4; float t = 0.f;
#pragma unroll
            for (int k = 0; k < 4; ++k) t += __uint_as_float(__hip_atomic_load(sl + k, __ATOMIC_RELAXED, __HIP_MEMORY_SCOPE_AGENT));
            Stab[rowl] = 1.0f / sqrtf(t * (1.0f / 1024.0f) + 1e-6f); }
        asm volatile("s_waitcnt vmcnt(0) lgkmcnt(0)\n\ts_barrier" ::: "memory");
        f32x4 g[2][2];
#pragma unroll
        for (int bj = 0; bj < 2; ++bj) { g[bj][0] = *(const f32x4*)(gain + col0 + bj * HALF); g[bj][1] = *(const f32x4*)(gain + col0 + bj * HALF + 4); }
#pragma unroll
        for (int ai = 0; ai < 2; ++ai)
#pragma unroll
            for (int m = 0; m < 4; ++m) { const int row = row0 + ai * HALF + m * 16; const float rs = Stab[ai * HALF + wr * 64 + m * 16 + fr];
#pragma unroll
                for (int bj = 0; bj < 2; ++bj) { const size_t off = (size_t)row * 1024 + col0 + bj * HALF;
                    *(f32x4*)(out + off) = acc[ai][bj][m][0] * rs * g[bj][0]; *(f32x4*)(out + off + 4) = acc[ai][bj][m][1] * rs * g[bj][1]; } }
        asm volatile("s_waitcnt lgkmcnt(0)" ::: "memory");
    }
};

template <class Epi, class Sched, bool ALIGN_EPI = false, bool SP2 = false>
__device__ __forceinline__ void gemm_phase(PG8_LAS unsigned char* lds, const Gemm g, const Sched& S, const Epi& E) {
    int tid = threadIdx.x; asm volatile("" : "+v"(tid));
    const int wid = __builtin_amdgcn_readfirstlane(tid >> 6), lane = tid & 63, wr = wid >> 2, wc = wid & 3, fr = lane & 15, fq = lane >> 4;
    const int K = g.K, nt = K / BK;
    unsigned voffA[2], voffB[2];
#pragma unroll
    for (int i = 0; i < 2; ++i) { int R, C; stage_rc(tid * 16 + i * 8192, R, C); const int Rb = Epi::PERM ? ((R & ~31) + perm32(R & 31)) : R;
        voffA[i] = (unsigned)(R * g.lda + C) * 2u; voffB[i] = (unsigned)(Rb * g.ldb + C) * 2u; }
    const size_t kstep = (size_t)(BK * 2);
    const size_t hstepA = (size_t)HALF * g.lda * 2, hstepB = (size_t)HALF * g.ldb * 2;
        const unsigned ldsw = (unsigned)wid * 1024u;
    const int aoff = lds_byte(wr * 64 + fr, fq * 8), boff = lds_byte(wc * 32 + fr, fq * 8);
#define PG8_SA(b, h) (((b) * 2 + (h)) * HTB)
#define PG8_SB(b, h) ((4 + (b) * 2 + (h)) * HTB)
#define PG8_STAGE(bufoff, gbase, voff) do { _Pragma("unroll") for (int _i = 0; _i < 2; ++_i) \
        __builtin_amdgcn_global_load_lds((const unsigned*)((const char*)(gbase) + (voff)[_i]), (PG8_LAS unsigned*)(lds + (bufoff) + ldsw + _i * 8192), 16, 0, 0); } while (0)
#define PG8_LDA(dst, b, h) do { _Pragma("unroll") for (int m = 0; m < 4; ++m) _Pragma("unroll") for (int k = 0; k < 2; ++k) dst[m][k] = *(const PG8_LAS bf16x8*)(lds + PG8_SA(b, h) + aoff + m * 2048 + k * 1024); } while (0)
#define PG8_LDB(dst, b, h) do { _Pragma("unroll") for (int n = 0; n < 2; ++n) _Pragma("unroll") for (int k = 0; k < 2; ++k) dst[n][k] = *(const PG8_LAS bf16x8*)(lds + PG8_SB(b, h) + boff + n * 2048 + k * 1024); } while (0)
#define PG8_MMA(ai, bj, At, Bt) do { __builtin_amdgcn_s_setprio(1); _Pragma("unroll") for (int m = 0; m < 4; ++m) _Pragma("unroll") for (int n = 0; n < 2; ++n) _Pragma("unroll") for (int k = 0; k < 2; ++k) \
        acc[ai][bj][m][n] = __builtin_amdgcn_mfma_f32_16x16x32_bf16(Bt[n][k], At[m][k], acc[ai][bj][m][n], 0, 0, 0); __builtin_amdgcn_s_setprio(0); } while (0)
#define PG8_WAIT_V(n) asm volatile("s_waitcnt vmcnt(" #n ")" ::: "memory")
#define PG8_WAIT_V8R() asm volatile("s_cmp_eq_u32 %0, 0\n\ts_cbranch_scc1 .Lw8_%=\n\ts_waitcnt vmcnt(24)\n\ts_branch .Lwd_%=\n.Lw8_%=:\n\ts_waitcnt vmcnt(8)\n.Lwd_%=:" :: "s"(relax) : "memory", "scc")
#define PG8_WAIT_L(n) asm volatile("s_waitcnt lgkmcnt(" #n ")" ::: "memory")
#define PG8_BAR __builtin_amdgcn_s_barrier()
#define PG8_SCHED __builtin_amdgcn_sched_barrier(0)
    Unit cur, nxt; int ui = 0;
    if (!S.next(0, cur)) return;
    f32x4 acc[2][2][4][2];
#pragma unroll
    for (int a = 0; a < 2; ++a)
#pragma unroll
        for (int b = 0; b < 2; ++b)
#pragma unroll
            for (int m = 0; m < 4; ++m)
#pragma unroll
                for (int n = 0; n < 2; ++n) acc[a][b][m][n] = (f32x4){0.f, 0.f, 0.f, 0.f};
    bf16x8 At[4][2], B0[2][2], B1[2][2];
    const char* cA = cur.a; const char* cB = cur.b;
    S.a_ready(cur);
    if constexpr (SP2) {
        PG8_STAGE(PG8_SB(0, 0), cB, voffB); PG8_STAGE(PG8_SB(0, 1), cB + hstepB, voffB); PG8_STAGE(PG8_SA(0, 0), cA, voffA); PG8_STAGE(PG8_SA(0, 1), cA + hstepA, voffA);
        if (wr == 1) PG8_BAR;
        PG8_WAIT_V(2); PG8_BAR;
        PG8_STAGE(PG8_SB(1, 0), cB + kstep, voffB); PG8_STAGE(PG8_SA(1, 0), cA + kstep, voffA); PG8_STAGE(PG8_SB(1, 1), cB + hstepB + kstep, voffB);
        PG8_WAIT_V(6); PG8_BAR;
    } else {
        PG8_STAGE(PG8_SB(0, 0), cB, voffB); PG8_STAGE(PG8_SA(0, 0), cA, voffA); PG8_STAGE(PG8_SB(0, 1), cB + hstepB, voffB); PG8_STAGE(PG8_SA(0, 1), cA + hstepA, voffA);
        if (wr == 1) PG8_BAR;
        PG8_WAIT_V(4); PG8_BAR;
        PG8_STAGE(PG8_SB(1, 0), cB + kstep, voffB); PG8_STAGE(PG8_SA(1, 0), cA + kstep, voffA); PG8_STAGE(PG8_SB(1, 1), cB + hstepB + kstep, voffB);
        PG8_WAIT_V(6); PG8_BAR;
    }
    for (;;) {
        const bool has_next = S.next(ui + 1, nxt);
        const char* nA = has_next ? nxt.a : cA; const char* nB = has_next ? nxt.b : cB;
        for (int t = 0; t < nt; t += 2) {
            const bool last = (t == nt - 2);
            const int relax = __builtin_amdgcn_readfirstlane(((t == 0) && (ui > 0)) ? 1 : 0);
            const char* a1 = cA + (size_t)(t + 1) * kstep;
            const char* a2 = last ? nA : cA + (size_t)(t + 2) * kstep; const char* b2 = last ? nB : cB + (size_t)(t + 2) * kstep;
            const char* a3 = a2 + kstep; const char* b3 = b2 + kstep;
            if (last && has_next) S.a_ready(nxt);
            if constexpr (SP2) {
            PG8_LDB(B0, 0, 0); PG8_LDB(B1, 0, 1); PG8_SCHED; PG8_LDA(At, 0, 0); PG8_STAGE(PG8_SA(1, 1), a1 + hstepA, voffA);
            PG8_WAIT_V8R(); PG8_WAIT_L(0); PG8_BAR; PG8_MMA(0, 0, At, B0); PG8_MMA(0, 1, At, B1); PG8_BAR; PG8_SCHED;
            PG8_LDA(At, 0, 1); PG8_STAGE(PG8_SB(0, 0), b2, voffB); PG8_STAGE(PG8_SB(0, 1), b2 + hstepB, voffB); PG8_STAGE(PG8_SA(0, 0), a2, voffA);
            PG8_WAIT_V8R(); PG8_WAIT_L(0); PG8_BAR; PG8_MMA(1, 0, At, B0); PG8_MMA(1, 1, At, B1); PG8_BAR; PG8_SCHED;
            PG8_LDB(B0, 1, 0); PG8_LDB(B1, 1, 1); PG8_SCHED; PG8_LDA(At, 1, 0); PG8_STAGE(PG8_SA(0, 1), a2 + hstepA, voffA);
            PG8_WAIT_V(8); PG8_WAIT_L(0); PG8_BAR; PG8_MMA(0, 0, At, B0); PG8_MMA(0, 1, At, B1); PG8_BAR; PG8_SCHED;
            PG8_LDA(At, 1, 1); PG8_STAGE(PG8_SB(1, 0), b3, voffB); PG8_STAGE(PG8_SB(1, 1), b3 + hstepB, voffB); PG8_STAGE(PG8_SA(1, 0), a3, voffA);
            PG8_WAIT_V(8); PG8_WAIT_L(0); PG8_BAR; PG8_MMA(1, 0, At, B0); PG8_MMA(1, 1, At, B1); PG8_BAR; PG8_SCHED;
            } else {
            PG8_LDB(B0, 0, 0); PG8_SCHED; PG8_LDA(At, 0, 0); PG8_STAGE(PG8_SA(1, 1), a1 + hstepA, voffA);
            PG8_WAIT_L(8); PG8_BAR; PG8_WAIT_L(0); PG8_MMA(0, 0, At, B0); PG8_BAR; PG8_SCHED;
            PG8_LDB(B1, 0, 1); PG8_STAGE(PG8_SB(0, 0), b2, voffB);
            PG8_BAR; PG8_WAIT_L(0); PG8_MMA(0, 1, At, B1); PG8_BAR;
            PG8_LDA(At, 0, 1); PG8_STAGE(PG8_SA(0, 0), a2, voffA);
            PG8_BAR; PG8_WAIT_L(0); PG8_MMA(1, 0, At, B0); PG8_BAR; PG8_SCHED;
            PG8_STAGE(PG8_SB(0, 1), b2 + hstepB, voffB);
            PG8_WAIT_V(6); PG8_BAR; PG8_MMA(1, 1, At, B1); PG8_BAR;
            PG8_LDB(B0, 1, 0); PG8_SCHED; PG8_LDA(At, 1, 0); PG8_STAGE(PG8_SA(0, 1), a2 + hstepA, voffA);
            PG8_WAIT_L(8); PG8_BAR; PG8_WAIT_L(0); PG8_MMA(0, 0, At, B0); PG8_BAR; PG8_SCHED;
            PG8_LDB(B1, 1, 1); PG8_STAGE(PG8_SB(1, 0), b3, voffB);
            PG8_BAR; PG8_WAIT_L(0); PG8_MMA(0, 1, At, B1); PG8_BAR;
            PG8_LDA(At, 1, 1); PG8_STAGE(PG8_SA(1, 0), a3, voffA);
            PG8_BAR; PG8_WAIT_L(0); PG8_MMA(1, 0, At, B0); PG8_BAR; PG8_SCHED;
            PG8_STAGE(PG8_SB(1, 1), b3 + hstepB, voffB);
            PG8_WAIT_V(6); PG8_BAR; PG8_MMA(1, 1, At, B1); PG8_BAR;
            }
        }
        if constexpr (ALIGN_EPI) { if (wr == 0) PG8_BAR; }
        if constexpr (!Epi::AFTER_DRAIN) { E(acc, cur, wr, wc, fr, fq); S.done(cur); }
        if (!has_next) break;
#pragma unroll
        for (int a = 0; a < 2; ++a)
#pragma unroll
            for (int b = 0; b < 2; ++b)
#pragma unroll
                for (int m = 0; m < 4; ++m)
#pragma unroll
                    for (int n = 0; n < 2; ++n) acc[a][b][m][n] = (f32x4){0.f, 0.f, 0.f, 0.f};
        cur = nxt; cA = nA; cB = nB; ++ui;
        if constexpr (ALIGN_EPI) { if (wr == 1) PG8_BAR; }
    }
    PG8_WAIT_V(0);
    if constexpr (!ALIGN_EPI) { if (wr == 0) PG8_BAR; }
    PG8_BAR;
    if constexpr (Epi::AFTER_DRAIN) { E.fused(acc, cur, wr, wc, fr, fq, lds, wid, lane); S.done(cur); }
#undef PG8_SA
#undef PG8_SB
#undef PG8_STAGE
#undef PG8_LDA
#undef PG8_LDB
#undef PG8_MMA
#undef PG8_WAIT_V
#undef PG8_WAIT_L
#undef PG8_BAR
#undef PG8_SCHED
}}

struct SchedStd {
    pg8::StaticOrder so; const char* A; const char* B; size_t tA, tB, bstride; int bshift;
    __device__ __forceinline__ void init(const void* A_, int lda, const void* B_, int ldb, int M, int N, int G, int c, int bshift_ = 30, size_t bstride_ = 0) {
        so.init(M, N, G, c); A = (const char*)A_; B = (const char*)B_; tA = (size_t)256 * lda * 2; tB = (size_t)256 * ldb * 2; bshift = bshift_; bstride = bstride_; }
    __device__ __forceinline__ bool next(int i, pg8::Unit& u) const { if (!so.next(i, u)) return false; u.a = A + (size_t)u.pm * tA; u.b = B + (size_t)u.pn * tB + (size_t)(u.pm >> bshift) * bstride; return true; }
    __device__ __forceinline__ void a_ready(const pg8::Unit&) const {}
    __device__ __forceinline__ void done(const pg8::Unit&) const {}
};
struct SchedMt {
    int G, c; const char* KV; const char* WqS;
    __device__ __forceinline__ bool next(int i, pg8::Unit& u) const { const int L = i * G + c; if (L >= 128) return false; const int b = L >> 4, h = (L >> 2) & 3, pn = L & 3;
        u.pm = b * 4 + h; u.pn = pn; u.a = KV + ((size_t)(b * 256) * 2048 + h * 256) * 2; u.b = WqS + ((size_t)pn * 256 * 1024 + h * 256) * 2; return true; }
    __device__ __forceinline__ void a_ready(const pg8::Unit&) const {}
    __device__ __forceinline__ void done(const pg8::Unit&) const {}
};
struct SchedNt {
    int G, c; const char* KV; const char* WoT;
    __device__ __forceinline__ bool next(int i, pg8::Unit& u) const { const int L = i * G + ((c + G / 2) % G); if (L >= 128) return false; const int b = L >> 4, pmc = (L >> 2) & 3, h = L & 3;
        u.pm = b * 4 + pmc; u.pn = h; u.a = WoT + ((size_t)pmc * 256 * 1024 + h * 256) * 2; u.b = KV + ((size_t)(b * 256) * 2048 + 1024 + h * 256) * 2; return true; }
    __device__ __forceinline__ void a_ready(const pg8::Unit&) const {}
    __device__ __forceinline__ void done(const pg8::Unit&) const {}
};

constexpr int NB = 8, SEQ = 4096, DM = 1024, MTOK = NB * SEQ, MEMLEN = 256, MMEM = NB * MEMLEN, INC = 3072, FF = 4096, AW = 512;
constexpr float EPS = 1e-6f, LOG2E = 1.4426950408889634f;
constexpr int NWAVES = 8;
constexpr size_t MiB = 1u << 20;
constexpr size_t WS_WIN = 1 * MiB, WS_WOUT = 7 * MiB, WS_WQS = 9 * MiB, WS_WKV = 11 * MiB, WS_WO = 15 * MiB, WS_WUP = 17 * MiB, WS_WDN = 25 * MiB;
constexpr size_t WS_MEMN = 33 * MiB, WS_KV = 37 * MiB, WS_MT = 45 * MiB, WS_NT = 61 * MiB, WS_SS1 = 77 * MiB, WS_SS2 = 79 * MiB;
constexpr size_t WS_H1 = 96 * MiB;
constexpr size_t WS_PROJ = 160 * MiB;
constexpr size_t WS_QKV = 256 * MiB;
constexpr int CONVP = 1536;
constexpr int HIDP = 4096 + 64;
constexpr size_t WS_MRG = 358 * MiB;
constexpr size_t WS_HID = 96 * MiB;
constexpr size_t WS_LSE = 82 * MiB;
constexpr size_t WS_OP01 = 96 * MiB;
constexpr size_t WS_OP2 = 422 * MiB;
constexpr size_t WS_END = 454 * MiB;
static_assert(WS_HID + (size_t)MTOK * HIDP * 2 <= WS_MRG && WS_MRG + (size_t)MTOK * 1024 * 2 <= WS_OP2 && WS_OP2 + (size_t)MTOK * AW * 2 <= WS_END, "d_ws map");
constexpr int RING_BYTES = 131072, XCH_OFF = RING_BYTES, LDS_BYTES = RING_BYTES + 8192 + 4096;

#define LAS __attribute__((address_space(3)))
typedef unsigned short bf16;
typedef float f32x4 __attribute__((ext_vector_type(4)));
typedef unsigned u32x4 __attribute__((ext_vector_type(4)));
typedef unsigned u32x2 __attribute__((ext_vector_type(2)));
#define LDS_WAIT() asm volatile("s_waitcnt lgkmcnt(0)" ::: "memory")
__device__ __forceinline__ unsigned f2bf(float f) { unsigned u = __builtin_bit_cast(unsigned, f); return (u + 0x7fffu + ((u >> 16) & 1u)) >> 16; }
__device__ __forceinline__ unsigned pk2(float lo, float hi) { return f2bf(lo) | (f2bf(hi) << 16); }
__device__ __forceinline__ float bf2f(unsigned v) { return __uint_as_float(v << 16); }
__device__ __forceinline__ float wave_sum(float v) {
#pragma unroll
    for (int o = 1; o < 64; o <<= 1) v += __shfl_xor(v, o);
    return v;
}

__device__ __forceinline__ void p0_transpose_item(const float* W, int K, int N, bf16* WT, const float* gain, LAS float* scr, int item, int lane) {
    const int nblk = N / 32, kb = item / nblk, nb = item % nblk, k0 = 64 * kb, n0 = 32 * nb;
    f32x4 v[8];
#pragma unroll
    for (int i = 0; i < 8; ++i) v[i] = __builtin_nontemporal_load((const f32x4*)(W + (size_t)(k0 + 8 * i + (lane >> 3)) * N + n0 + 4 * (lane & 7)));
#pragma unroll
    for (int i = 0; i < 8; ++i) { const int kk = 8 * i + (lane >> 3); const float g = gain ? gain[k0 + kk] : 1.0f; LAS float* d = scr + kk * 33 + 4 * (lane & 7);
        d[0] = v[i][0] * g; d[1] = v[i][1] * g; d[2] = v[i][2] * g; d[3] = v[i][3] * g; }
    LDS_WAIT(); asm volatile("" ::: "memory");
    const int c = lane & 7;
#pragma unroll
    for (int j = 0; j < 4; ++j) { const int n = (lane >> 3) + 8 * j; const LAS float* s = scr + (8 * c) * 33 + n;
        u32x4 o; o.x = pk2(s[0 * 33], s[1 * 33]); o.y = pk2(s[2 * 33], s[3 * 33]); o.z = pk2(s[4 * 33], s[5 * 33]); o.w = pk2(s[6 * 33], s[7 * 33]);
        *(u32x4*)(WT + (size_t)(n0 + n) * K + k0 + 8 * c) = o; }
    LDS_WAIT(); asm volatile("" ::: "memory");
}
__device__ __forceinline__ void rms_row_to_bf16(const float* xrow, const float* g, bf16* orow, int lane) {
    const f32x4* xr = (const f32x4*)xrow + lane; const f32x4* gr = (const f32x4*)g + lane;
    f32x4 v[4]; float s = 0.f;
#pragma unroll
    for (int j = 0; j < 4; ++j) { v[j] = xr[64 * j]; s += (v[j][0] * v[j][0] + v[j][1] * v[j][1]) + (v[j][2] * v[j][2] + v[j][3] * v[j][3]); }
    const float rs = 1.0f / sqrtf(wave_sum(s) * (1.0f / 1024.0f) + EPS);
    u32x2* o8 = (u32x2*)orow + lane;
#pragma unroll
    for (int j = 0; j < 4; ++j) { const f32x4 gv = gr[64 * j]; u32x2 o; o.x = pk2(v[j][0] * rs * gv[0], v[j][1] * rs * gv[1]); o.y = pk2(v[j][2] * rs * gv[2], v[j][3] * rs * gv[3]); o8[64 * j] = o; }
}

struct Args { const float* in[17]; float* out; unsigned char* ws; int ph_lo, ph_hi; };
enum { I_X = 0, I_MEM, I_GMIX, I_WIN, I_CONVW, I_GATT, I_GCONV, I_WOUT, I_GX, I_GMEM, I_WQ, I_WKV, I_WO, I_GMLP, I_WUP, I_WDN, I_GFIN };

__device__ __forceinline__ void p0_rows(const Args& a, int gw, int NGW, int lane) {
    const float* X = a.in[I_X]; const float* g = a.in[I_GMIX]; bf16* H1 = (bf16*)(a.ws + WS_H1);
    const f32x4* gr = (const f32x4*)g + lane;
#pragma unroll 1
    for (int m = gw; m < MTOK; m += 2 * NGW) {
        const int m2 = m + NGW; const bool has2 = m2 < MTOK;
        const f32x4* x0 = (const f32x4*)(X + (size_t)m * 1024) + lane; const f32x4* x1 = (const f32x4*)(X + (size_t)(has2 ? m2 : m) * 1024) + lane;
        f32x4 v[4], w[4]; float s0 = 0.f, s1 = 0.f;
#pragma unroll
        for (int j = 0; j < 4; ++j) { v[j] = __builtin_nontemporal_load(x0 + 64 * j); w[j] = __builtin_nontemporal_load(x1 + 64 * j); }
#pragma unroll
        for (int j = 0; j < 4; ++j) { s0 += (v[j][0] * v[j][0] + v[j][1] * v[j][1]) + (v[j][2] * v[j][2] + v[j][3] * v[j][3]); s1 += (w[j][0] * w[j][0] + w[j][1] * w[j][1]) + (w[j][2] * w[j][2] + w[j][3] * w[j][3]); }
#pragma unroll
        for (int o = 1; o < 64; o <<= 1) { s0 += __shfl_xor(s0, o); s1 += __shfl_xor(s1, o); }
        const float r0 = 1.0f / sqrtf(s0 * (1.0f / 1024.0f) + EPS), r1 = 1.0f / sqrtf(s1 * (1.0f / 1024.0f) + EPS);
        u32x2* o0 = (u32x2*)(H1 + (size_t)m * 1024) + lane; u32x2* o1 = (u32x2*)(H1 + (size_t)m2 * 1024) + lane;
#pragma unroll
        for (int j = 0; j < 4; ++j) { const f32x4 gv = gr[64 * j]; u32x2 o; o.x = pk2(v[j][0] * r0 * gv[0], v[j][1] * r0 * gv[1]); o.y = pk2(v[j][2] * r0 * gv[2], v[j][3] * r0 * gv[3]); o0[64 * j] = o;
            if (has2) { u32x2 p; p.x = pk2(w[j][0] * r1 * gv[0], w[j][1] * r1 * gv[1]); p.y = pk2(w[j][2] * r1 * gv[2], w[j][3] * r1 * gv[3]); o1[64 * j] = p; } }
    }
}
__device__ __forceinline__ void p0_prologue(const Args& a, LAS unsigned char* lds, int gw, int NGW, int wave, int lane) {
    unsigned char* ws = a.ws;
    LAS float* scr = (LAS float*)(lds + wave * 16384);
    constexpr int I_IN = 16 * 96, I_OUT = 16 * 32, I_KV = 16 * 64, I_O = 16 * 32, I_UP = 16 * 128, I_DN = 64 * 32;
    constexpr int NITEMS = I_IN + I_OUT + I_KV + I_O + I_UP + I_DN;
    const bool rows_first = (wave & 1) != 0;
    if (rows_first) p0_rows(a, gw, NGW, lane);
    for (int it = gw; it < NITEMS; it += NGW) {
        int r = it;
        if (r < I_IN) { p0_transpose_item(a.in[I_WIN], 1024, 3072, (bf16*)(ws + WS_WIN), nullptr, scr, r, lane); continue; } r -= I_IN;
        if (r < I_OUT) { p0_transpose_item(a.in[I_WOUT], 1024, 1024, (bf16*)(ws + WS_WOUT), nullptr, scr, r, lane); continue; } r -= I_OUT;
        if (r < I_KV) { p0_transpose_item(a.in[I_WKV], 1024, 2048, (bf16*)(ws + WS_WKV), nullptr, scr, r, lane); continue; } r -= I_KV;
        if (r < I_O) { p0_transpose_item(a.in[I_WO], 1024, 1024, (bf16*)(ws + WS_WO), nullptr, scr, r, lane); continue; } r -= I_O;
        if (r < I_UP) { p0_transpose_item(a.in[I_WUP], 1024, 4096, (bf16*)(ws + WS_WUP), a.in[I_GMLP], scr, r, lane); continue; } r -= I_UP;
        p0_transpose_item(a.in[I_WDN], 4096, 1024, (bf16*)(ws + WS_WDN), nullptr, scr, r, lane);
    }
    for (int c = gw; c < 1024; c += NGW) { const float g = a.in[I_GX][c]; const f32x4* wr_ = (const f32x4*)(a.in[I_WQ] + (size_t)c * 1024) + lane; u32x2* o8 = (u32x2*)((bf16*)(ws + WS_WQS) + (size_t)c * 1024) + lane;
#pragma unroll
        for (int j = 0; j < 4; ++j) { const f32x4 v = wr_[64 * j]; u32x2 o; o.x = pk2(v[0] * g, v[1] * g); o.y = pk2(v[2] * g, v[3] * g); o8[64 * j] = o; } }
    for (int m = gw; m < MMEM; m += NGW) rms_row_to_bf16(a.in[I_MEM] + (size_t)m * 1024, a.in[I_GMEM], (bf16*)(ws + WS_MEMN) + (size_t)m * 1024, lane);
    if (!rows_first) p0_rows(a, gw, NGW, lane);
}

__device__ __forceinline__ void unpack8(const u32x4 w, float (&f)[8]) {
#pragma unroll
    for (int i = 0; i < 4; ++i) { f[2 * i] = __uint_as_float(w[i] << 16); f[2 * i + 1] = __uint_as_float(w[i] & 0xffff0000u); }
}
typedef float f32x16 __attribute__((ext_vector_type(16)));
typedef short bf16x8 __attribute__((ext_vector_type(8)));
typedef short s16x4 __attribute__((ext_vector_type(4)));
__device__ __forceinline__ float swap32_max(float v) { auto rr = __builtin_amdgcn_permlane32_swap(__float_as_uint(v), __float_as_uint(v), false, false); return fmaxf(__uint_as_float(rr[0]), __uint_as_float(rr[1])); }
__device__ __forceinline__ float swap32_sum(float v) { auto rr = __builtin_amdgcn_permlane32_swap(__float_as_uint(v), __float_as_uint(v), false, false); return __uint_as_float(rr[0]) + __uint_as_float(rr[1]); }
__device__ __forceinline__ s16x4 vtr(const LAS unsigned char* p) { return __builtin_bit_cast(s16x4, __builtin_amdgcn_ds_read_tr16_b64_v4i16((LAS s16x4*)p)); }
__device__ __forceinline__ bf16x8 packp(const f32x16& p, int b) { u32x4 w; w.x = pg8::cvt_pk_bf16(p[b], p[b + 1]); w.y = pg8::cvt_pk_bf16(p[b + 2], p[b + 3]); w.z = pg8::cvt_pk_bf16(p[b + 4], p[b + 5]); w.w = pg8::cvt_pk_bf16(p[b + 6], p[b + 7]); return __builtin_bit_cast(bf16x8, w); }

constexpr int P2_UNITS = 3072, P2_KIMG = 0, P2_VIMG = 49152, P2_STAGE = 98304;
struct P2Unit { const bf16* pb; int h, p, dil, r, m0; size_t tokbase; };
__device__ __forceinline__ P2Unit p2_decode(int L, const bf16* proj) {
    P2Unit u; const int xcd = L & 7, idx = L >> 3, b = idx / 48, rem = idx % 48, uu = rem & 15; u.p = rem >> 4; u.h = xcd;
    const int dsh = 2 * u.p; u.dil = 1 << dsh; const int chunk = uu & ((16 >> dsh) - 1); u.r = uu >> (4 - dsh); u.m0 = chunk * 256;
    u.pb = proj + (size_t)(b * 8 + u.h) * SEQ * 64; u.tokbase = (size_t)b * SEQ; return u;
}
constexpr size_t QKV_PLANE = (size_t)MTOK * AW;
__device__ __forceinline__ void p2a_attn(const bf16* proj, bf16* op01, bf16* op2, float* lse, LAS unsigned char* lds, int G, int bx, int wave, int tid) {
    const int lane = tid & 63, r32 = lane & 31, hi = lane >> 5;
    const int vr_off = (4 * hi + ((lane & 15) >> 2)) * 64 + ((lane >> 4) & 1) * 32 + (lane & 3) * 8;
    u32x4 kreg[6], vreg[6], qn[4];
    LAS unsigned char* stage = lds + P2_STAGE + wave * 4096;
#define P2A_ISSUE(LL) do { const P2Unit un = p2_decode((LL), proj); \
        _Pragma("unroll") for (int j = 0; j < 4; ++j) { const int row = (lane >> 3) + 8 * j; \
          qn[j] = *(const u32x4*)(un.pb + (size_t)((un.m0 + 32 * wave + row) * un.dil + un.r) * 64 + (lane & 7) * 8); } \
        _Pragma("unroll") for (int j = 0; j < 6; ++j) { const int q = tid + 512 * j, row = q >> 3, ch = q & 7; const int pos = max(un.m0 - 128 + row, 0); \
          const bf16* kp = un.pb + QKV_PLANE + (size_t)(pos * un.dil + un.r) * 64 + ch * 8; kreg[j] = *(const u32x4*)kp; vreg[j] = *(const u32x4*)(kp + QKV_PLANE); } } while (0)
    const int xcd_ = bx & 7, cl = bx >> 3;
    const bool g256 = (G == 256);
    const int ncl = g256 ? 32 : (G + 7 - xcd_) / 8;
    const int cnt = g256 ? (cl < 8 ? 9 : 13) : (384 - cl + ncl - 1) / ncl;
#define P2A_IDX(k) ((g256 && (k) >= 9) ? 288 + 24 * ((k) - 9) + (cl - 8) : ncl * (k) + cl)
    if (cnt > 0) P2A_ISSUE(P2A_IDX(0) * 8 + xcd_);
#pragma unroll 1
    for (int k = 0; k < cnt; ++k) {
        const int L = P2A_IDX(k) * 8 + xcd_;
        const P2Unit u = p2_decode(L, proj);
        __syncthreads();
#pragma unroll
        for (int j = 0; j < 6; ++j) { const int q = tid + 512 * j, row = q >> 3, ch = q & 7;
            *(LAS u32x4*)(lds + P2_KIMG + row * 128 + ((ch ^ (row & 7)) * 16)) = kreg[j];
            *(LAS u32x4*)(lds + P2_VIMG + (row >> 5) * 4096 + (ch >> 2) * 2048 + (row & 31) * 64 + (ch & 3) * 16) = vreg[j]; }
#pragma unroll
        for (int j = 0; j < 4; ++j) { const int row = (lane >> 3) + 8 * j; *(LAS u32x4*)(stage + row * 128 + (((lane & 7) ^ (row & 7)) * 16)) = qn[j]; }
        asm volatile("" ::: "memory");
        bf16x8 qf[4];
#pragma unroll
        for (int d0 = 0; d0 < 4; ++d0) qf[d0] = *(const LAS bf16x8*)(stage + r32 * 128 + (((2 * d0 + hi) ^ (r32 & 7)) * 16));
        __syncthreads();
        if (k + 1 < cnt) P2A_ISSUE(P2A_IDX(k + 1) * 8 + xcd_);
        f32x16 pt[5];
#pragma unroll
        for (int j = 0; j < 5; ++j) {
            const int kt = wave + j;
            if (u.m0 - 128 + 32 * kt >= 0) {
                const LAS unsigned char* kb = lds + P2_KIMG + kt * 4096 + r32 * 128;
#pragma unroll
                for (int i = 0; i < 16; ++i) pt[j][i] = 0.f;
                bf16x8 kf[4];
#pragma unroll
                for (int d0 = 0; d0 < 4; ++d0) kf[d0] = *(const LAS bf16x8*)(kb + (((2 * d0 + hi) ^ (r32 & 7)) * 16));
#pragma unroll
                for (int d0 = 0; d0 < 4; ++d0) pt[j] = __builtin_amdgcn_mfma_f32_32x32x16_bf16(kf[d0], qf[d0], pt[j], 0, 0, 0);
            } else {
#pragma unroll
                for (int i = 0; i < 16; ++i) pt[j][i] = -1.0e30f;
            }
        }
#pragma unroll
        for (int i = 0; i < 16; ++i) { const int kk = (i & 3) + 8 * (i >> 2) + 4 * hi;
            pt[0][i] = (kk >= r32) ? pt[0][i] : -1.0e30f;
            pt[4][i] = (kk <= r32) ? pt[4][i] : -1.0e30f; }
        float mxa = fmaxf(pt[0][0], pt[1][0]), mxb = fmaxf(pt[2][0], pt[3][0]), mxc = pt[4][0];
#pragma unroll
        for (int i = 1; i < 16; ++i) { mxa = fmaxf(mxa, fmaxf(pt[0][i], pt[1][i])); mxb = fmaxf(mxb, fmaxf(pt[2][i], pt[3][i])); mxc = fmaxf(mxc, pt[4][i]); }
        const float m_run = swap32_max(fmaxf(fmaxf(mxa, mxb), mxc));
        float la = 0.f, lb = 0.f;
#pragma unroll
        for (int j = 0; j < 5; ++j)
#pragma unroll
            for (int i = 0; i < 16; i += 2) { pt[j][i] = __builtin_amdgcn_exp2f(pt[j][i] - m_run); pt[j][i + 1] = __builtin_amdgcn_exp2f(pt[j][i + 1] - m_run); la += pt[j][i]; lb += pt[j][i + 1]; }
        float l = la + lb;
        f32x16 o0, o1;
#pragma unroll
        for (int i = 0; i < 16; ++i) { o0[i] = 0.f; o1[i] = 0.f; }
#pragma unroll
        for (int j = 0; j < 5; ++j) {
            const int kt = wave + j;
            if (u.m0 - 128 + 32 * kt >= 0) {
                const bf16x8 pf0 = packp(pt[j], 0), pf1 = packp(pt[j], 8);
                const LAS unsigned char* vb = lds + P2_VIMG + kt * 4096 + vr_off;
#pragma unroll
                for (int ks = 0; ks < 2; ++ks) {
                    const s16x4 a0 = vtr(vb + ks * 1024), a1 = vtr(vb + ks * 1024 + 512), b0 = vtr(vb + 2048 + ks * 1024), b1 = vtr(vb + 2048 + ks * 1024 + 512);
                    const bf16x8 v0 = {a0[0], a0[1], a0[2], a0[3], a1[0], a1[1], a1[2], a1[3]}, v1 = {b0[0], b0[1], b0[2], b0[3], b1[0], b1[1], b1[2], b1[3]};
                    o0 = __builtin_amdgcn_mfma_f32_32x32x16_bf16(v0, ks ? pf1 : pf0, o0, 0, 0, 0);
                    o1 = __builtin_amdgcn_mfma_f32_32x32x16_bf16(v1, ks ? pf1 : pf0, o1, 0, 0, 0);
                }
            }
        }
        l = swap32_sum(l);
        const float inv = 1.0f / l;
        const size_t token = u.tokbase + (size_t)(u.m0 + 32 * wave + r32) * u.dil + u.r;
        bf16* obase = (u.p == 2 ? op2 : op01 + (size_t)u.p * MTOK * AW) + u.h * 64 + (lane & 7) * 8;
#pragma unroll
        for (int g4 = 0; g4 < 4; ++g4) {
            u32x2 wa, wb;
            wa.x = pg8::cvt_pk_bf16(o0[4 * g4] * inv, o0[4 * g4 + 1] * inv); wa.y = pg8::cvt_pk_bf16(o0[4 * g4 + 2] * inv, o0[4 * g4 + 3] * inv);
            wb.x = pg8::cvt_pk_bf16(o1[4 * g4] * inv, o1[4 * g4 + 1] * inv); wb.y = pg8::cvt_pk_bf16(o1[4 * g4 + 2] * inv, o1[4 * g4 + 3] * inv);
            *(LAS u32x2*)(stage + r32 * 128 + ((g4 ^ (r32 & 7)) * 16) + 8 * hi) = wa;
            *(LAS u32x2*)(stage + r32 * 128 + (((4 + g4) ^ (r32 & 7)) * 16) + 8 * hi) = wb;
        }
        asm volatile("" ::: "memory");
#pragma unroll
        for (int j = 0; j < 4; ++j) { const int row = (lane >> 3) + 8 * j;
            const u32x4 v = *(const LAS u32x4*)(stage + row * 128 + (((lane & 7) ^ (row & 7)) * 16));
            *(u32x4*)(obase + (u.tokbase + (size_t)(u.m0 + 32 * wave + row) * u.dil + u.r) * AW) = v; }
        if (hi == 0) lse[((size_t)u.p * MTOK + token) * 8 + u.h] = m_run + __builtin_amdgcn_logf(l);
    }
#undef P2A_ISSUE
#undef P2A_IDX
}
struct P3Tok { float l0, l1, l2; u32x4 a0, a1, a2, bg, cg0, xc0, cg1, xc1, cg2, xc2; };
__device__ __forceinline__ void p3_load(P3Tok& k, const bf16* proj, const bf16* op01, const bf16* op2, const float* lse, int token, int lane) {
    const int hh = lane >> 3, c0 = 8 * lane, t = token & (SEQ - 1); const bf16* prow = proj + (size_t)token * CONVP; const u32x4 z = {0u, 0u, 0u, 0u};
    k.l0 = __builtin_nontemporal_load(lse + (size_t)token * 8 + hh); k.l1 = __builtin_nontemporal_load(lse + ((size_t)MTOK + token) * 8 + hh); k.l2 = __builtin_nontemporal_load(lse + ((size_t)2 * MTOK + token) * 8 + hh);
    k.a0 = __builtin_nontemporal_load((const u32x4*)(op01 + (size_t)token * AW + c0)); k.a1 = __builtin_nontemporal_load((const u32x4*)(op01 + ((size_t)MTOK + token) * AW + c0)); k.a2 = __builtin_nontemporal_load((const u32x4*)(op2 + (size_t)token * AW + c0));
    k.bg = *(const u32x4*)(prow + c0); k.cg0 = *(const u32x4*)(prow + 512 + c0); k.xc0 = *(const u32x4*)(prow + 1024 + c0);
    k.cg1 = t >= 1 ? *(const u32x4*)(prow - CONVP + 512 + c0) : z; k.xc1 = t >= 1 ? *(const u32x4*)(prow - CONVP + 1024 + c0) : z;
    k.cg2 = t >= 2 ? *(const u32x4*)(prow - 2 * CONVP + 512 + c0) : z; k.xc2 = t >= 2 ? *(const u32x4*)(prow - 2 * CONVP + 1024 + c0) : z;
}
__device__ __forceinline__ void p3_compute(const P3Tok& k, const float* conv_w, const float* g_a, const float* g_c, bf16* merged, int token, int lane) {
    const int c0 = 8 * lane;
    const float mx = fmaxf(k.l0, fmaxf(k.l1, k.l2));
    float w0 = __builtin_amdgcn_exp2f(k.l0 - mx), w1 = __builtin_amdgcn_exp2f(k.l1 - mx), w2 = __builtin_amdgcn_exp2f(k.l2 - mx);
    const float winv = 1.0f / (w0 + w1 + w2); w0 *= winv; w1 *= winv; w2 *= winv;
    float a0[8], a1[8], a2[8], bg[8], cg0[8], xc0[8], cg1[8], xc1[8], cg2[8], xc2[8];
    unpack8(k.a0, a0); unpack8(k.a1, a1); unpack8(k.a2, a2); unpack8(k.bg, bg); unpack8(k.cg0, cg0); unpack8(k.xc0, xc0); unpack8(k.cg1, cg1); unpack8(k.xc1, xc1); unpack8(k.cg2, cg2); unpack8(k.xc2, xc2);
    float y[8], yc[8]; float ss = 0.f, sc = 0.f;
#pragma unroll
    for (int e = 0; e < 8; ++e) { y[e] = w0 * a0[e] + w1 * a1[e] + w2 * a2[e]; ss += y[e] * y[e];
        const float cw0 = conv_w[c0 + e], cw1 = conv_w[512 + c0 + e], cw2 = conv_w[1024 + c0 + e];
        yc[e] = bg[e] * (cw0 * (cg2[e] * xc2[e]) + cw1 * (cg1[e] * xc1[e]) + cw2 * (cg0[e] * xc0[e])); sc += yc[e] * yc[e]; }
#pragma unroll
    for (int o = 1; o < 64; o <<= 1) { ss += __shfl_xor(ss, o); sc += __shfl_xor(sc, o); }
    const float rs = 1.0f / sqrtf(ss * (1.0f / 512.0f) + EPS), rc = 1.0f / sqrtf(sc * (1.0f / 512.0f) + EPS);
    u32x4 o, oc;
#pragma unroll
    for (int i = 0; i < 4; ++i) { o[i] = pk2(y[2 * i] * rs * g_a[c0 + 2 * i], y[2 * i + 1] * rs * g_a[c0 + 2 * i + 1]); oc[i] = pk2(yc[2 * i] * rc * g_c[c0 + 2 * i], yc[2 * i + 1] * rc * g_c[c0 + 2 * i + 1]); }
    *(u32x4*)(merged + (size_t)token * 1024 + c0) = o; *(u32x4*)(merged + (size_t)token * 1024 + 512 + c0) = oc;
}
__device__ __forceinline__ void p3_merge(const bf16* proj, const bf16* op01, const bf16* op2, const float* lse, const float* conv_w, const float* g_a, const float* g_c, bf16* merged, int gw, int NGW, int lane) {
#pragma unroll 1
    for (int token = gw; token < MTOK; token += 2 * NGW) {
        const int tok2 = token + NGW; const bool has2 = tok2 < MTOK;
        P3Tok k0, k1;
        p3_load(k0, proj, op01, op2, lse, token, lane); p3_load(k1, proj, op01, op2, lse, has2 ? tok2 : token, lane);
        p3_compute(k0, conv_w, g_a, g_c, merged, token, lane);
        if (has2) p3_compute(k1, conv_w, g_a, g_c, merged, tok2, lane);
    }
}
__device__ __forceinline__ void p8_final(float* out, const float* g, int gw, int NGW, int lane) {
    for (int m = gw; m < MTOK; m += NGW) {
        f32x4* xr = (f32x4*)(out + (size_t)m * 1024) + lane; const f32x4* gr = (const f32x4*)g + lane;
        f32x4 v[4]; float s = 0.f;
#pragma unroll
        for (int j = 0; j < 4; ++j) { v[j] = xr[64 * j]; s += (v[j][0] * v[j][0] + v[j][1] * v[j][1]) + (v[j][2] * v[j][2] + v[j][3] * v[j][3]); }
        const float rs = 1.0f / sqrtf(wave_sum(s) * (1.0f / 1024.0f) + EPS);
#pragma unroll
        for (int j = 0; j < 4; ++j) xr[64 * j] = v[j] * rs * gr[64 * j];
    }
}

#define RLX_AGENT __ATOMIC_RELAXED, __HIP_MEMORY_SCOPE_AGENT
#define XB_TMO      128
#define XB_XCNT(j)  (256  + 64 * (j))
#define XB_XSUB(j)  (1280 + 64 * (j))
#define XB_XGEN(j)  (2304 + 64 * (j))
#define XB_TOP      3328
#define XB_TOPGEN   3392
#define XCD_BAR_WORDS 3456
#define XB_SPIN_CAP (1u << 18)

__device__ __forceinline__ unsigned xb_ld(unsigned* p)              { return __hip_atomic_load(p, __ATOMIC_RELAXED, __HIP_MEMORY_SCOPE_AGENT); }
__device__ __forceinline__ unsigned xb_add(unsigned* p, unsigned v) { return __hip_atomic_fetch_add(p, v, __ATOMIC_RELAXED, __HIP_MEMORY_SCOPE_AGENT); }
__device__ __forceinline__ unsigned xb_xcc_id() { return (unsigned)__builtin_amdgcn_s_getreg((3 << 11) | 20) & 0xFu; }
#define XB_SPIN(cond, bar) do { unsigned _sp = 0; while (cond) { __builtin_amdgcn_s_sleep(1); \
    if ((++_sp & 255u) == 0u) { if (xb_ld(&(bar)[XB_TMO])) break; if (_sp > XB_SPIN_CAP) { atomicAdd(&(bar)[XB_TMO], 1u); break; } } } } while (0)

struct XcdBarrier {
    unsigned* bar; unsigned x;
    volatile LAS unsigned* st;
};

__device__ __forceinline__ XcdBarrier xcd_barrier_post(unsigned* bar, volatile LAS unsigned* st) {
    XcdBarrier b; b.bar = bar; b.x = xb_xcc_id(); b.st = st;
    if (threadIdx.x == 0) (void)xb_add(&bar[XB_XCNT(b.x)], 1u);
    return b;
}
__device__ __forceinline__ void xcd_barrier_complete(unsigned* bar, unsigned x, unsigned& nloc, unsigned& nx) {
    const unsigned G = gridDim.x * gridDim.y * gridDim.z;
    unsigned sum, cnt, mine, sp = 0u;
    for (;;) {
        sum = 0u; cnt = 0u; mine = 0u;
#pragma unroll
        for (unsigned j = 0; j < 16; ++j) { const unsigned c = xb_ld(&bar[XB_XCNT(j)]); sum += c; cnt += (c > 0u) ? 1u : 0u; mine = (j == x) ? c : mine; }
        if (sum == G) break;
        __builtin_amdgcn_s_sleep(1);
        if ((++sp & 255u) == 0u) { if (xb_ld(&bar[XB_TMO])) break; if (sp > XB_SPIN_CAP) { atomicAdd(&bar[XB_TMO], 1u); break; } }
    }
    nloc = mine > 0u ? mine : 1u; nx = cnt > 0u ? cnt : 1u;
}

__device__ __forceinline__ void xcd_barrier(const XcdBarrier& b) {
    asm volatile("s_waitcnt vmcnt(0)" ::: "memory");
    __syncthreads();
    if (threadIdx.x == 0) {
        unsigned* bar = b.bar;
        __builtin_amdgcn_s_waitcnt(0);
        unsigned nloc = b.st[0], nx = b.st[1];
        if (nloc == 0u) { xcd_barrier_complete(bar, b.x, nloc, nx); b.st[0] = nloc; b.st[1] = nx; }
        const unsigned old = xb_add(&bar[XB_XSUB(b.x)], 1u);
        const unsigned gen = old / nloc;
        if (old + 1u == (gen + 1u) * nloc) {
            __builtin_amdgcn_fence(__ATOMIC_RELEASE, "agent");
            asm volatile("s_waitcnt vmcnt(0)" ::: "memory");
            const unsigned og = xb_add(&bar[XB_TOP], 1u);
            const unsigned tg = og / nx;
            if (og + 1u == (tg + 1u) * nx) xb_add(&bar[XB_TOPGEN], 1u);
            else XB_SPIN(xb_ld(&bar[XB_TOPGEN]) == tg, bar);
            __builtin_amdgcn_fence(__ATOMIC_ACQUIRE, "agent");
            xb_add(&bar[XB_XGEN(b.x)], 1u);
            asm volatile("s_waitcnt vmcnt(0)" ::: "memory");
        } else {
            XB_SPIN(xb_ld(&bar[XB_XGEN(b.x)]) == gen, bar);
            __builtin_amdgcn_fence(__ATOMIC_ACQUIRE, "agent");
            asm volatile("s_waitcnt vmcnt(0)" ::: "memory");
        }
    }
    __syncthreads();
}
constexpr int NPHASE = 10;
constexpr int CW_PANEL = 4096;
#ifndef DUP_PHASE
#define DUP_PHASE -1
#endif
#define NREP(k) ((k) == DUP_PHASE ? 2 : 1)
__global__ void __launch_bounds__(NWAVES * 64, 2) mega(Args a) {
    extern __shared__ __attribute__((aligned(16))) unsigned char lds_raw[];
    LAS unsigned char* lds = (LAS unsigned char*)lds_raw;
    const int wave = __builtin_amdgcn_readfirstlane((int)threadIdx.x >> 6);
#define LANE() ({ int t_ = threadIdx.x; asm volatile("" : "+v"(t_)); t_ & 63; })
    const int G = gridDim.x, bx = blockIdx.x;
    const int gw = bx * NWAVES + wave, NGW = G * NWAVES;
    unsigned char* ws = a.ws;
    const int lo = a.ph_lo, hi = a.ph_hi;
    if (lo < 0) cg::this_grid().sync();
    volatile LAS unsigned* MISC = (volatile LAS unsigned*)(lds + XCH_OFF + 8192);
    if (threadIdx.x < 64) MISC[threadIdx.x] = 0u;
    __syncthreads();
    XcdBarrier bar; bar.bar = (unsigned*)ws; bar.x = 0; bar.st = nullptr;
    if (hi - lo > 1) bar = xcd_barrier_post((unsigned*)ws, MISC + 8);
#define IN(k) (lo <= (k) && (k) < hi)
#define SEAM(k) do { if (IN(k) && IN((k) + 1)) xcd_barrier(bar); } while (0)
    bf16* const H1 = (bf16*)(ws + WS_H1); bf16* const PROJ = (bf16*)(ws + WS_PROJ); bf16* const MRG = (bf16*)(ws + WS_MRG); bf16* const HID = (bf16*)(ws + WS_HID);
    bf16* const KV = (bf16*)(ws + WS_KV); bf16* const MT = (bf16*)(ws + WS_MT); bf16* const NT = (bf16*)(ws + WS_NT);
    float* const SS1 = (float*)(ws + WS_SS1); float* const SS2 = (float*)(ws + WS_SS2);

    enum { PH_PRO = 0, PH_PROJ, PH_ATTN, PH_MERGE, PH_WOUT, PH_S, PH_PN, PH_UP, PH_DOWN, PH_FINAL };
    bf16* const QKVH = (bf16*)(ws + WS_QKV); bf16* const OP01 = (bf16*)(ws + WS_OP01); bf16* const OP2 = (bf16*)(ws + WS_OP2); float* const LSE = (float*)(ws + WS_LSE);
    if (IN(PH_PRO)) for (int rep = 0; rep < NREP(PH_PRO); ++rep) { p0_prologue(a, lds, gw, NGW, wave, LANE()); __syncthreads(); }
    SEAM(PH_PRO);
    if (IN(PH_PROJ)) for (int rep = 0; rep < NREP(PH_PROJ); ++rep) {
        { pg8::Gemm g{1024, 1024, 1024}; SchedStd S; S.init(H1, 1024, ws + WS_WIN, 1024, MTOK, INC, G, bx); pg8::EpiProj E{PROJ, QKVH, 0.125f * LOG2E};
          pg8::gemm_phase<pg8::EpiProj, SchedStd, true, true>(lds, g, S, E); }
    }
    SEAM(PH_PROJ);
    if (IN(PH_ATTN)) for (int rep = 0; rep < NREP(PH_ATTN); ++rep) {
        { pg8::Gemm g{1024, 1024, 1024}; SchedStd S; S.init(ws + WS_MEMN, 1024, ws + WS_WKV, 1024, MMEM, 2048, G, bx); pg8::EpiStore E{KV, 2048, 0, 1.0f};
          pg8::gemm_phase<pg8::EpiStore, SchedStd, true, true>(lds, g, S, E); }
        { int t_ = threadIdx.x; asm volatile("" : "+v"(t_)); p2a_attn(QKVH, OP01, OP2, LSE, lds, G, bx, wave, t_); }
    }
    SEAM(PH_ATTN);
    if (IN(PH_MERGE)) for (int rep = 0; rep < NREP(PH_MERGE); ++rep) {
        int k256 = 256; asm volatile("" : "+s"(k256));
        { pg8::Gemm g{k256, 2048, 1024}; SchedMt S{G, bx, (const char*)KV, (const char*)(ws + WS_WQS)}; pg8::EpiStore E{MT, 1024, 0, 1.0f};
          pg8::gemm_phase<pg8::EpiStore, SchedMt, true, true>(lds, g, S, E); }
        { pg8::Gemm g{k256, 1024, 2048}; SchedNt S{G, bx, (const char*)KV, (const char*)(ws + WS_WO)}; pg8::EpiStore E{NT, 1024, 0, 1.0f};
          pg8::gemm_phase<pg8::EpiStore, SchedNt, true, true>(lds, g, S, E); }
        p3_merge(PROJ, OP01, OP2, LSE, a.in[I_CONVW], a.in[I_GATT], a.in[I_GCONV], MRG, gw, NGW, LANE());
    }
    SEAM(PH_MERGE);
    if (IN(PH_WOUT)) for (int rep = 0; rep < NREP(PH_WOUT); ++rep) { pg8::Gemm g{1024, 1024, 1024}; SchedStd S; S.init(MRG, 1024, ws + WS_WOUT, 1024, MTOK, 1024, G, bx); pg8::EpiResid<false> E{a.in[I_X], nullptr, H1, SS1};
        pg8::gemm_phase<pg8::EpiResid<false>, SchedStd, false, true>(lds, g, S, E); }
    SEAM(PH_WOUT);
    if (IN(PH_S)) for (int rep = 0; rep < NREP(PH_S); ++rep) { pg8::Gemm g{1024, 1024, 1024}; SchedStd S; S.init(H1, 1024, MT, 1024, MTOK, 1024, G, bx, 4, (size_t)1024 * 1024 * 2); pg8::EpiSoftmax E{SS1, PROJ, (LAS float*)(lds + XCH_OFF)};
        pg8::gemm_phase<pg8::EpiSoftmax, SchedStd, true, true>(lds, g, S, E); }
    SEAM(PH_S);
    if (IN(PH_PN)) for (int rep = 0; rep < NREP(PH_PN); ++rep) { pg8::Gemm g{1024, 1024, 1024}; SchedStd S; S.init(PROJ, 1024, NT, 1024, MTOK, 1024, G, bx, 4, (size_t)1024 * 1024 * 2); pg8::EpiResid<true> E{H1, nullptr, MRG, SS2};
        pg8::gemm_phase<pg8::EpiResid<true>, SchedStd, true, true>(lds, g, S, E); }
    SEAM(PH_PN);
    if (IN(PH_UP)) for (int rep = 0; rep < NREP(PH_UP); ++rep) { pg8::Gemm g{1024, 1024, 1024}; SchedStd S; S.init(MRG, 1024, ws + WS_WUP, 1024, MTOK, FF, G, bx); pg8::EpiRelu2 E{SS2, HID, HIDP};
        pg8::gemm_phase<pg8::EpiRelu2, SchedStd, true, true>(lds, g, S, E); }
    SEAM(PH_UP);
    const bool fuse_final = (G == 256) && IN(PH_DOWN) && IN(PH_FINAL);
    if (IN(PH_DOWN)) for (int rep = 0; rep < NREP(PH_DOWN); ++rep) { pg8::Gemm g{4096, HIDP, 4096}; SchedStd S; S.init(HID, HIDP, ws + WS_WDN, 4096, MTOK, 1024, G, bx);
        if (fuse_final) { pg8::EpiFinal E{MRG, a.out, a.in[I_GFIN], (unsigned*)(ws + WS_SS1), (unsigned*)ws + CW_PANEL, (LAS float*)(lds + XCH_OFF)};
            pg8::gemm_phase<pg8::EpiFinal, SchedStd, true, true>(lds, g, S, E); }
        else { pg8::EpiResid<true> E{MRG, a.out, nullptr, nullptr};
            pg8::gemm_phase<pg8::EpiResid<true>, SchedStd, true, true>(lds, g, S, E); } }
    if (!fuse_final) {
        SEAM(PH_DOWN);
        if (IN(PH_FINAL)) p8_final(a.out, a.in[I_GFIN], gw, NGW, LANE());
    }
#undef IN
#undef SEAM
}

extern "C" void kernel_launch(void* const* d_in, const int* in_sizes, int n_in, void* d_out, int out_size, void* d_ws, size_t ws_size, hipStream_t stream) {
    static int grid = 0;
    if (grid == 0) {
        if (n_in != 17 || in_sizes[0] != MTOK * DM || out_size != MTOK * DM || ws_size < WS_END) { fprintf(stderr, "kernel_launch: unexpected shapes (n_in %d, in0 %d, out %d, ws %zu); nothing launched\n", n_in, n_in > 0 ? in_sizes[0] : -1, out_size, ws_size); grid = -1; return; }
        int dev = 0, cus = 0, per_cu = 0;
        if (hipGetDevice(&dev) != hipSuccess || hipDeviceGetAttribute(&cus, hipDeviceAttributeMultiprocessorCount, dev) != hipSuccess) { grid = -1; return; }
        if (hipFuncSetAttribute((const void*)mega, hipFuncAttributeMaxDynamicSharedMemorySize, LDS_BYTES) != hipSuccess) { fprintf(stderr, "kernel_launch: hipFuncSetAttribute failed\n"); grid = -1; return; }
        if (hipOccupancyMaxActiveBlocksPerMultiprocessor(&per_cu, (const void*)mega, NWAVES * 64, LDS_BYTES) != hipSuccess || per_cu < 1) { fprintf(stderr, "kernel_launch: occupancy query says %d\n", per_cu); per_cu = 1; }
        (void)hipGetLastError();
        grid = cus * per_cu;
    }
    if (grid < 0) return;
    Args a{};
    for (int i = 0; i < 17; ++i) a.in[i] = (const float*)d_in[i];
    a.out = (float*)d_out; a.ws = (unsigned char*)d_ws;
#if N_LAUNCHES == 1
    if (hipMemsetAsync(d_ws, 0, 65536, stream) != hipSuccess) { fprintf(stderr, "kernel_launch: hipMemsetAsync failed\n"); return; }
    a.ph_lo = 0; a.ph_hi = NPHASE;
    void* args[] = {&a};
    hipError_t e = hipLaunchCooperativeKernel((const void*)mega, dim3(grid), dim3(NWAVES * 64), args, LDS_BYTES, stream);
    if (e != hipSuccess) fprintf(stderr, "kernel_launch: cooperative launch failed: %s (grid %d)\n", hipGetErrorString(e), grid);
#else
    for (int li = 0; li < NPHASE; ++li) { a.ph_lo = li; a.ph_hi = li + 1; hipLaunchKernelGGL(mega, dim3(grid), dim3(NWAVES * 64), LDS_BYTES, stream, a); }
#endif
}
```

```cpp
#include <hip/hip_runtime.h>
#include <hip/hip_cooperative_groups.h>
#include <cstdio>
#include <cstdint>
namespace cg = cooperative_groups;

#ifndef N_LAUNCHES
#define N_LAUNCHES 1
#endif

namespace pg8 {
#define PG8_LAS __attribute__((address_space(3)))
typedef unsigned short bf16_t;
typedef short bf16x8 __attribute__((ext_vector_type(8)));
typedef float f32x4 __attribute__((ext_vector_type(4)));
typedef unsigned u32x4 __attribute__((ext_vector_type(4)));
constexpr int BM = 256, BK = 64, HALF = 128, HTB = HALF * BK * 2  , STAGE_BYTES = 8 * HTB, NXCD = 8, WGM = 8;

__host__ __device__ __forceinline__ int lds_byte(int r, int c) { const int st = (r >> 4) * 2 + (c >> 5), rr = r & 15, cc = c & 31, ob = rr * 64 + cc * 2; return st * 1024 + (ob ^ (((ob >> 9) & 1) << 5)); }
__host__ __device__ __forceinline__ void stage_rc(int b, int& R, int& C) { const int st = b / 1024, sb = b % 1024, swz = sb ^ (((sb >> 9) & 1) << 5); R = (st >> 1) * 16 + swz / 64; C = (st & 1) * 32 + (swz % 64) / 2; }
__host__ __device__ __forceinline__ int perm32(int rho) { const int n = rho >> 4, i = rho & 15; return 8 * (i >> 2) + 4 * n + (i & 3); }

struct Unit { int pm, pn; const char* a; const char* b; };
struct Gemm { int K, lda, ldb; };

struct StaticOrder {
    int nM, nN, nwg, G, c;
    __host__ __device__ void init(int M, int N, int G_, int c_) { nM = M / BM; nN = N / BM; nwg = nM * nN; G = G_; c = c_; }
    __host__ __device__ bool next(int i, Unit& u) const {
        const long L = (long)i * G + c; if (L >= nwg) return false;
        int wgid = (int)L; { const int q = nwg / NXCD, r = nwg % NXCD, xcd = wgid % NXCD, off = wgid / NXCD; wgid = (xcd < r ? xcd * (q + 1) : r * (q + 1) + (xcd - r) * q) + off; }
        const int nig = WGM * nN, gid = wgid / nig, fm = gid * WGM, gsz = (nM - fm) < WGM ? (nM - fm) : WGM;
        u.pm = fm + ((wgid % nig) % gsz); u.pn = (wgid % nig) / gsz; return true;
    }
};
__device__ __forceinline__ unsigned cvt_pk_bf16(float lo, float hi) { unsigned r; asm volatile("v_cvt_pk_bf16_f32 %0, %1, %2" : "=v"(r) : "v"(lo), "v"(hi)); return r; }

__device__ __forceinline__ u32x4 pack8(f32x4 v0, f32x4 v1) { u32x4 w; w.x = cvt_pk_bf16(v0[0], v0[1]); w.y = cvt_pk_bf16(v0[2], v0[3]); w.z = cvt_pk_bf16(v1[0], v1[1]); w.w = cvt_pk_bf16(v1[2], v1[3]); return w; }
__device__ __forceinline__ float sum16(const float* sp) { const f32x4 a = *(const f32x4*)sp, b = *(const f32x4*)(sp + 4), c = *(const f32x4*)(sp + 8), d = *(const f32x4*)(sp + 12);
    return ((a[0] + a[1]) + (a[2] + a[3])) + ((b[0] + b[1]) + (b[2] + b[3])) + ((c[0] + c[1]) + (c[2] + c[3])) + ((d[0] + d[1]) + (d[2] + d[3])); }

__device__ __forceinline__ void row_scales(const float* SS, int row0, int fq, float (&rs)[2][4]) {
    f32x4 t[2][4];
#pragma unroll
    for (int ai = 0; ai < 2; ++ai)
#pragma unroll
        for (int m = 0; m < 4; ++m) t[ai][m] = *(const f32x4*)(SS + (size_t)(row0 + ai * HALF + m * 16) * 16 + fq * 4);
#pragma unroll
    for (int ai = 0; ai < 2; ++ai)
#pragma unroll
        for (int m = 0; m < 4; ++m) { float s = (t[ai][m][0] + t[ai][m][1]) + (t[ai][m][2] + t[ai][m][3]); s += __shfl_xor(s, 16); s += __shfl_xor(s, 32); rs[ai][m] = __builtin_amdgcn_rsqf(s * (1.0f / 1024.0f) + 1e-6f); }
}
struct EpiStore {
    static constexpr bool PERM = true, AFTER_DRAIN = false;
    bf16_t* O; int ldc; int npn_scaled; float scale0;
    __device__ __forceinline__ void operator()(f32x4 (&acc)[2][2][4][2], const Unit& u, int wr, int wc, int fr, int fq) const {
        const int row0 = u.pm * BM + wr * 64 + fr, col0 = u.pn * BM + wc * 32 + 8 * fq;
        const float sc = (u.pn < npn_scaled) ? scale0 : 1.0f;
#pragma unroll
        for (int ai = 0; ai < 2; ++ai)
#pragma unroll
            for (int m = 0; m < 4; ++m) { bf16_t* rowp = O + (size_t)(row0 + ai * HALF + m * 16) * ldc + col0;
#pragma unroll
                for (int bj = 0; bj < 2; ++bj) *(u32x4*)(rowp + bj * HALF) = pack8(acc[ai][bj][m][0] * sc, acc[ai][bj][m][1] * sc); }
    }
};
struct EpiProj {
    static constexpr bool PERM = true, AFTER_DRAIN = false;
    bf16_t* PC; bf16_t* QKV; float scale0;
    __device__ __forceinline__ void operator()(f32x4 (&acc)[2][2][4][2], const Unit& u, int wr, int wc, int fr, int fq) const {
        const int row0 = u.pm * BM + wr * 64 + fr;
        if (u.pn >= 6) {
            const int col0 = (u.pn - 6) * BM + wc * 32 + 8 * fq;
#pragma unroll
            for (int ai = 0; ai < 2; ++ai)
#pragma unroll
                for (int m = 0; m < 4; ++m) { bf16_t* rowp = PC + (size_t)(row0 + ai * HALF + m * 16) * 1536 + col0;
#pragma unroll
                    for (int bj = 0; bj < 2; ++bj) *(u32x4*)(rowp + bj * HALF) = pack8(acc[ai][bj][m][0], acc[ai][bj][m][1]); }
        } else {
            const float sc = (u.pn < 2) ? scale0 : 1.0f;
            const int which = u.pn >> 1, d = (wc & 1) * 32 + 8 * fq;
            bf16_t* base = QKV + (size_t)which * 32768 * 512 + d;
#pragma unroll
            for (int ai = 0; ai < 2; ++ai)
#pragma unroll
                for (int m = 0; m < 4; ++m) { const int row = row0 + ai * HALF + m * 16;
#pragma unroll
                    for (int bj = 0; bj < 2; ++bj) { const int h = 4 * (u.pn & 1) + 2 * bj + (wc >> 1);
                        *(u32x4*)(base + ((size_t)((row >> 12) * 8 + h) * 4096 + (row & 4095)) * 64) = pack8(acc[ai][bj][m][0] * sc, acc[ai][bj][m][1] * sc); } }
        }
    }
};
template <bool BASE_BF16> struct EpiResid {
    static constexpr bool PERM = true, AFTER_DRAIN = false;
    const void* base; float* out; bf16_t* xb; float* SS;
    __device__ __forceinline__ void operator()(f32x4 (&acc)[2][2][4][2], const Unit& u, int wr, int wc, int fr, int fq) const {
        const int row0 = u.pm * BM + wr * 64 + fr, col0 = u.pn * BM + wc * 32 + 8 * fq;
#pragma unroll
        for (int ai = 0; ai < 2; ++ai) {
            u32x4 wb[4][2]; f32x4 fb[4][2][2];
#pragma unroll
            for (int m = 0; m < 4; ++m)
#pragma unroll
                for (int bj = 0; bj < 2; ++bj) { const size_t off = (size_t)(row0 + ai * HALF + m * 16) * 1024 + col0 + bj * HALF;
                    if (BASE_BF16) wb[m][bj] = *(const u32x4*)((const bf16_t*)base + off);
                    else { fb[m][bj][0] = *(const f32x4*)((const float*)base + off); fb[m][bj][1] = *(const f32x4*)((const float*)base + off + 4); } }
#pragma unroll
            for (int m = 0; m < 4; ++m) { const int row = row0 + ai * HALF + m * 16; float ss = 0.f;
#pragma unroll
                for (int bj = 0; bj < 2; ++bj) { const size_t off = (size_t)row * 1024 + col0 + bj * HALF;
                    f32x4 b0, b1;
                    if (BASE_BF16) { const u32x4 w = wb[m][bj];
                        b0 = (f32x4){__uint_as_float(w.x << 16), __uint_as_float(w.x & 0xffff0000u), __uint_as_float(w.y << 16), __uint_as_float(w.y & 0xffff0000u)};
                        b1 = (f32x4){__uint_as_float(w.z << 16), __uint_as_float(w.z & 0xffff0000u), __uint_as_float(w.w << 16), __uint_as_float(w.w & 0xffff0000u)}; }
                    else { b0 = fb[m][bj][0]; b1 = fb[m][bj][1]; }
                    const f32x4 v0 = acc[ai][bj][m][0] + b0, v1 = acc[ai][bj][m][1] + b1;
                    if (out) { *(f32x4*)(out + off) = v0; *(f32x4*)(out + off + 4) = v1; }
                    if (xb) *(u32x4*)(xb + off) = pack8(v0, v1);
                    ss += ((v0[0] * v0[0] + v0[1] * v0[1]) + (v0[2] * v0[2] + v0[3] * v0[3])) + ((v1[0] * v1[0] + v1[1] * v1[1]) + (v1[2] * v1[2] + v1[3] * v1[3])); }
                if (SS) { ss += __shfl_xor(ss, 16); ss += __shfl_xor(ss, 32); if (fq == 0) SS[(size_t)row * 16 + u.pn * 4 + wc] = ss; } }
            asm volatile("" ::: "memory");
        }
    }
};
struct EpiRelu2 {
    static constexpr bool PERM = true, AFTER_DRAIN = false;
    const float* SS; bf16_t* O; int ldo;
    __device__ __forceinline__ void operator()(f32x4 (&acc)[2][2][4][2], const Unit& u, int wr, int wc, int fr, int fq) const {
        const int row0 = u.pm * BM + wr * 64 + fr, col0 = u.pn * BM + wc * 32 + 8 * fq;
        float rsv[2][4]; row_scales(SS, row0, fq, rsv);
#pragma unroll
        for (int ai = 0; ai < 2; ++ai)
#pragma unroll
            for (int m = 0; m < 4; ++m) { const int row = row0 + ai * HALF + m * 16;
                const float rs = rsv[ai][m];
                bf16_t* rowp = O + (size_t)row * ldo + col0;
#pragma unroll
                for (int bj = 0; bj < 2; ++bj) { f32x4 v0 = acc[ai][bj][m][0] * rs, v1 = acc[ai][bj][m][1] * rs;
#pragma unroll
                    for (int e = 0; e < 4; ++e) { const float a = fmaxf(v0[e], 0.f), b = fmaxf(v1[e], 0.f); v0[e] = a * a; v1[e] = b * b; }
                    __builtin_nontemporal_store(pack8(v0, v1), (u32x4*)(rowp + bj * HALF)); } }
    }
};
struct EpiSoftmax {
    static constexpr bool PERM = true, AFTER_DRAIN = false;
    const float* SS; bf16_t* P; PG8_LAS float* xch;
    __device__ __forceinline__ void operator()(f32x4 (&acc)[2][2][4][2], const Unit& u, int wr, int wc, int fr, int fq) const {
        const int row0 = u.pm * BM + wr * 64 + fr, col0 = u.pn * BM + wc * 32 + 8 * fq;
        float mw[2][4];
        float rsv[2][4]; row_scales(SS, row0, fq, rsv);
#pragma unroll
        for (int ai = 0; ai < 2; ++ai)
#pragma unroll
            for (int m = 0; m < 4; ++m) { const int rl = ai * HALF + wr * 64 + m * 16 + fr;
                const float sc = rsv[ai][m] * (0.0625f * 1.4426950408889634f);
                float mx = -3.0e38f;
#pragma unroll
                for (int bj = 0; bj < 2; ++bj)
#pragma unroll
                    for (int n = 0; n < 2; ++n) { f32x4 v = acc[ai][bj][m][n] * sc; acc[ai][bj][m][n] = v; mx = fmaxf(mx, fmaxf(fmaxf(v[0], v[1]), fmaxf(v[2], v[3]))); }
                mx = fmaxf(mx, __shfl_xor(mx, 16)); mx = fmaxf(mx, __shfl_xor(mx, 32));
                float l = 0.f;
#pragma unroll
                for (int bj = 0; bj < 2; ++bj)
#pragma unroll
                    for (int n = 0; n < 2; ++n) { f32x4 v = acc[ai][bj][m][n];
#pragma unroll
                        for (int e = 0; e < 4; ++e) { v[e] = __builtin_amdgcn_exp2f(v[e] - mx); l += v[e]; }
                        acc[ai][bj][m][n] = v; }
                l += __shfl_xor(l, 16); l += __shfl_xor(l, 32);
                mw[ai][m] = mx;
                if (fq == 0) { xch[rl * 8 + wc * 2] = mx; xch[rl * 8 + wc * 2 + 1] = l; } }
        asm volatile("s_waitcnt lgkmcnt(0)\n\ts_barrier" ::: "memory");
#pragma unroll
        for (int ai = 0; ai < 2; ++ai)
#pragma unroll
            for (int m = 0; m < 4; ++m) { const int row = row0 + ai * HALF + m * 16; const int rl = ai * HALF + wr * 64 + m * 16 + fr;
                const f32x4 x0 = *(const PG8_LAS f32x4*)(xch + rl * 8), x1 = *(const PG8_LAS f32x4*)(xch + rl * 8 + 4);
                const float M = fmaxf(fmaxf(x0[0], x0[2]), fmaxf(x1[0], x1[2]));
                const float L = (x0[1] * __builtin_amdgcn_exp2f(x0[0] - M) + x0[3] * __builtin_amdgcn_exp2f(x0[2] - M)) + (x1[1] * __builtin_amdgcn_exp2f(x1[0] - M) + x1[3] * __builtin_amdgcn_exp2f(x1[2] - M));
                const float fac = __builtin_amdgcn_exp2f(mw[ai][m] - M) * __builtin_amdgcn_rcpf(L);
                bf16_t* rowp = P + (size_t)row * 1024 + col0;
#pragma unroll
                for (int bj = 0; bj < 2; ++bj) __builtin_nontemporal_store(pack8(acc[ai][bj][m][0] * fac, acc[ai][bj][m][1] * fac), (u32x4*)(rowp + bj * HALF)); }
        asm volatile("s_waitcnt lgkmcnt(0)" ::: "memory");
    }
};

struct EpiFinal {
    static constexpr bool PERM = true, AFTER_DRAIN = false;
    const bf16_t* base; float* out; const float* gain; unsigned* slots; unsigned* cnt; PG8_LAS float* tab;
    __device__ __forceinline__ void operator()(f32x4 (&acc)[2][2][4][2], const Unit& u, int wr, int wc, int fr, int fq) const {
        const int row0 = u.pm * BM + wr * 64 + fr, col0 = u.pn * BM + wc * 32 + 8 * fq;
        const int lane = fr + 16 * fq, wid = wr * 4 + wc;
        PG8_LAS float* Ptab = tab; PG8_LAS float* Stab = tab + 1024;
#pragma unroll
        for (int ai = 0; ai < 2; ++ai)
#pragma unroll
            for (int m = 0; m < 4; ++m) { const int row = row0 + ai * HALF + m * 16; float ss = 0.f;
#pragma unroll
                for (int bj = 0; bj < 2; ++bj) { const size_t off = (size_t)row * 1024 + col0 + bj * HALF;
                    const u32x4 w = *(const u32x4*)(base + off);
                    const f32x4 b0 = (f32x4){__uint_as_float(w.x << 16), __uint_as_float(w.x & 0xffff0000u), __uint_as_float(w.y << 16), __uint_as_float(w.y & 0xffff0000u)};
                    const f32x4 b1 = (f32x4){__uint_as_float(w.z << 16), __uint_as_float(w.z & 0xffff0000u), __uint_as_float(w.w << 16), __uint_as_float(w.w & 0xffff0000u)};
                    const f32x4 v0 = acc[ai][bj][m][0] + b0, v1 = acc[ai][bj][m][1] + b1; acc[ai][bj][m][0] = v0; acc[ai][bj][m][1] = v1;
                    ss += ((v0[0] * v0[0] + v0[1] * v0[1]) + (v0[2] * v0[2] + v0[3] * v0[3])) + ((v1[0] * v1[0] + v1[1] * v1[1]) + (v1[2] * v1[2] + v1[3] * v1[3])); }
                ss += __shfl_xor(ss, 16); ss += __shfl_xor(ss, 32);
                if (fq == 0) Ptab[(ai * HALF + wr * 64 + m * 16 + fr) * 4 + wc] = ss; }
        asm volatile("s_waitcnt lgkmcnt(0)\n\ts_barrier" ::: "memory");
        const int rowl = wid * 32 + (lane & 31);
        if (lane < 32) { const f32x4 p = *(const PG8_LAS f32x4*)(Ptab + rowl * 4);
            __hip_atomic_store(slots + ((size_t)(u.pm * BM + rowl) * 4 + u.pn), __float_as_uint((p[0] + p[1]) + (p[2] + p[3])), __ATOMIC_RELAXED, __HIP_MEMORY_SCOPE_AGENT); }
        asm volatile("s_waitcnt vmcnt(0)" ::: "memory");
        if (lane == 0) __hip_atomic_fetch_add(cnt + 64 * u.pm, 1u, __ATOMIC_RELAXED, __HIP_MEMORY_SCOPE_AGENT);
        if (wid == 0) {
            unsigned sp = 0;
            while ((unsigned)__builtin_amdgcn_readfirstlane(__hip_atomic_load(cnt + 64 * u.pm, __ATOMIC_RELAXED, __HIP_MEMORY_SCOPE_AGENT)) < 32u) { __builtin_amdgcn_s_sleep(2); if (++sp > (1u << 22)) break; }
            __builtin_amdgcn_fence(__ATOMIC_ACQUIRE, "agent");
        }
        asm volatile("s_waitcnt vmcnt(0) lgkmcnt(0)\n\ts_barrier" ::: "memory");
        if (lane < 32) { const unsigned* sl = slots + (size_t)(u.pm * BM + rowl) * 4; float t = 0.f;
#pragma unroll
            for (int k = 0; k < 4; ++k) t += __uint_as_float(__hip_atomic_load(sl + k, __ATOMIC_RELAXED, __HIP_MEMORY_SCOPE_AGENT));
            Stab[rowl] = 1.0f / sqrtf(t * (1.0f / 1024.0f) + 1e-6f); }
        asm volatile("s_waitcnt vmcnt(0) lgkmcnt(0)\n\ts_barrier" ::: "memory");
        f32x4 g[2][2];
#pragma unroll
        for (int bj = 0; bj < 2; ++bj) { g[bj][0] = *(const f32x4*)(gain + col0 + bj * HALF); g[bj][1] = *(const f32x4*)(gain + col0 + bj * HALF + 4); }
#pragma unroll
        for (int ai = 0; ai < 2; ++ai)
#pragma unroll
            for (int m = 0; m < 4; ++m) { const int row = row0 + ai * HALF + m * 16; const float rs = Stab[ai * HALF + wr * 64 + m * 16 + fr];
#pragma unroll
                for (int bj = 0; bj < 2; ++bj) { const size_t off = (size_t)row * 1024 + col0 + bj * HALF;
                    *(f32x4*)(out + off) = acc[ai][bj][m][0] * rs * g[bj][0]; *(f32x4*)(out + off + 4) = acc[ai][bj][m][1] * rs * g[bj][1]; } }
        asm volatile("s_waitcnt lgkmcnt(0)" ::: "memory");
    }
};

template <class Epi, class Sched, bool ALIGN_EPI = false, bool SP2 = false>
__device__ __forceinline__ void gemm_phase(PG8_LAS unsigned char* lds, const Gemm g, const Sched& S, const Epi& E) {
    int tid = threadIdx.x; asm volatile("" : "+v"(tid));
    const int wid = __builtin_amdgcn_readfirstlane(tid >> 6), lane = tid & 63, wr = wid >> 2, wc = wid & 3, fr = lane & 15, fq = lane >> 4;
    const int K = g.K, nt = K / BK;
    unsigned voffA[2], voffB[2];
#pragma unroll
    for (int i = 0; i < 2; ++i) { int R, C; stage_rc(tid * 16 + i * 8192, R, C); const int Rb = Epi::PERM ? ((R & ~31) + perm32(R & 31)) : R;
        voffA[i] = (unsigned)(R * g.lda + C) * 2u; voffB[i] = (unsigned)(Rb * g.ldb + C) * 2u; }
    const size_t kstep = (size_t)(BK * 2);
    const size_t hstepA = (size_t)HALF * g.lda * 2, hstepB = (size_t)HALF * g.ldb * 2;
        const unsigned ldsw = (unsigned)wid * 1024u;
    const int aoff = lds_byte(wr * 64 + fr, fq * 8), boff = lds_byte(wc * 32 + fr, fq * 8);
#define PG8_SA(b, h) (((b) * 2 + (h)) * HTB)
#define PG8_SB(b, h) ((4 + (b) * 2 + (h)) * HTB)
#define PG8_STAGE(bufoff, gbase, voff) do { _Pragma("unroll") for (int _i = 0; _i < 2; ++_i) \
        __builtin_amdgcn_global_load_lds((const unsigned*)((const char*)(gbase) + (voff)[_i]), (PG8_LAS unsigned*)(lds + (bufoff) + ldsw + _i * 8192), 16, 0, 0); } while (0)
#define PG8_LDA(dst, b, h) do { _Pragma("unroll") for (int m = 0; m < 4; ++m) _Pragma("unroll") for (int k = 0; k < 2; ++k) dst[m][k] = *(const PG8_LAS bf16x8*)(lds + PG8_SA(b, h) + aoff + m * 2048 + k * 1024); } while (0)
#define PG8_LDB(dst, b, h) do { _Pragma("unroll") for (int n = 0; n < 2; ++n) _Pragma("unroll") for (int k = 0; k < 2; ++k) dst[n][k] = *(const PG8_LAS bf16x8*)(lds + PG8_SB(b, h) + boff + n * 2048 + k * 1024); } while (0)
#define PG8_MMA(ai, bj, At, Bt) do { __builtin_amdgcn_s_setprio(1); _Pragma("unroll") for (int m = 0; m < 4; ++m) _Pragma("unroll") for (int n = 0; n < 2; ++n) _Pragma("unroll") for (int k = 0; k < 2; ++k) \
        acc[ai][bj][m][n] = __builtin_amdgcn_mfma_f32_16x16x32_bf16(Bt[n][k], At[m][k], acc[ai][bj][m][n], 0, 0, 0); __builtin_amdgcn_s_setprio(0); } while (0)
#define PG8_WAIT_V(n) asm volatile("s_waitcnt vmcnt(" #n ")" ::: "memory")
#define PG8_WAIT_V8R() asm volatile("s_cmp_eq_u32 %0, 0\n\ts_cbranch_scc1 .Lw8_%=\n\ts_waitcnt vmcnt(24)\n\ts_branch .Lwd_%=\n.Lw8_%=:\n\ts_waitcnt vmcnt(8)\n.Lwd_%=:" :: "s"(relax) : "memory", "scc")
#define PG8_WAIT_L(n) asm volatile("s_waitcnt lgkmcnt(" #n ")" ::: "memory")
#define PG8_BAR __builtin_amdgcn_s_barrier()
#define PG8_SCHED __builtin_amdgcn_sched_barrier(0)
    Unit cur, nxt; int ui = 0;
    if (!S.next(0, cur)) return;
    f32x4 acc[2][2][4][2];
#pragma unroll
    for (int a = 0; a < 2; ++a)
#pragma unroll
        for (int b = 0; b < 2; ++b)
#pragma unroll
            for (int m = 0; m < 4; ++m)
#pragma unroll
                for (int n = 0; n < 2; ++n) acc[a][b][m][n] = (f32x4){0.f, 0.f, 0.f, 0.f};
    bf16x8 At[4][2], B0[2][2], B1[2][2];
    const char* cA = cur.a; const char* cB = cur.b;
    S.a_ready(cur);
    if constexpr (SP2) {
        PG8_STAGE(PG8_SB(0, 0), cB, voffB); PG8_STAGE(PG8_SB(0, 1), cB + hstepB, voffB); PG8_STAGE(PG8_SA(0, 0), cA, voffA); PG8_STAGE(PG8_SA(0, 1), cA + hstepA, voffA);
        if (wr == 1) PG8_BAR;
        PG8_WAIT_V(2); PG8_BAR;
        PG8_STAGE(PG8_SB(1, 0), cB + kstep, voffB); PG8_STAGE(PG8_SA(1, 0), cA + kstep, voffA); PG8_STAGE(PG8_SB(1, 1), cB + hstepB + kstep, voffB);
        PG8_WAIT_V(6); PG8_BAR;
    } else {
        PG8_STAGE(PG8_SB(0, 0), cB, voffB); PG8_STAGE(PG8_SA(0, 0), cA, voffA); PG8_STAGE(PG8_SB(0, 1), cB + hstepB, voffB); PG8_STAGE(PG8_SA(0, 1), cA + hstepA, voffA);
        if (wr == 1) PG8_BAR;
        PG8_WAIT_V(4); PG8_BAR;
        PG8_STAGE(PG8_SB(1, 0), cB + kstep, voffB); PG8_STAGE(PG8_SA(1, 0), cA + kstep, voffA); PG8_STAGE(PG8_SB(1, 1), cB + hstepB + kstep, voffB);
        PG8_WAIT_V(6); PG8_BAR;
    }
    for (;;) {
        const bool has_next = S.next(ui + 1, nxt);
        const char* nA = has_next ? nxt.a : cA; const char* nB = has_next ? nxt.b : cB;
        for (int t = 0; t < nt; t += 2) {
            const bool last = (t == nt - 2);
            const int relax = __builtin_amdgcn_readfirstlane(((t == 0) && (ui > 0)) ? 1 : 0);
            const char* a1 = cA + (size_t)(t + 1) * kstep;
            const char* a2 = last ? nA : cA + (size_t)(t + 2) * kstep; const char* b2 = last ? nB : cB + (size_t)(t + 2) * kstep;
            const char* a3 = a2 + kstep; const char* b3 = b2 + kstep;
            if (last && has_next) S.a_ready(nxt);
            if constexpr (SP2) {
            PG8_LDB(B0, 0, 0); PG8_LDB(B1, 0, 1); PG8_SCHED; PG8_LDA(At, 0, 0); PG8_STAGE(PG8_SA(1, 1), a1 + hstepA, voffA);
            PG8_WAIT_V8R(); PG8_WAIT_L(0); PG8_BAR; PG8_MMA(0, 0, At, B0); PG8_MMA(0, 1, At, B1); PG8_BAR; PG8_SCHED;
            PG8_LDA(At, 0, 1); PG8_STAGE(PG8_SB(0, 0), b2, voffB); PG8_STAGE(PG8_SB(0, 1), b2 + hstepB, voffB); PG8_STAGE(PG8_SA(0, 0), a2, voffA);
            PG8_WAIT_V8R(); PG8_WAIT_L(0); PG8_BAR; PG8_MMA(1, 0, At, B0); PG8_MMA(1, 1, At, B1); PG8_BAR; PG8_SCHED;
            PG8_LDB(B0, 1, 0); PG8_LDB(B1, 1, 1); PG8_SCHED; PG8_LDA(At, 1, 0); PG8_STAGE(PG8_SA(0, 1), a2 + hstepA, voffA);
            PG8_WAIT_V(8); PG8_WAIT_L(0); PG8_BAR; PG8_MMA(0, 0, At, B0); PG8_MMA(0, 1, At, B1); PG8_BAR; PG8_SCHED;
            PG8_LDA(At, 1, 1); PG8_STAGE(PG8_SB(1, 0), b3, voffB); PG8_STAGE(PG8_SB(1, 1), b3 + hstepB, voffB); PG8_STAGE(PG8_SA(1, 0), a3, voffA);
            PG8_WAIT_V(8); PG8_WAIT_L(0); PG8_BAR; PG8_MMA(1, 0, At, B0); PG8_MMA(1, 1, At, B1); PG8_BAR; PG8_SCHED;
            } else {
            PG8_LDB(B0, 0, 0); PG8_SCHED; PG8_LDA(At, 0, 0); PG8_STAGE(PG8_SA(1, 1), a1 + hstepA, voffA);
            PG8_WAIT_L(8); PG8_BAR; PG8_WAIT_L(0); PG8_MMA(0, 0, At, B0); PG8_BAR; PG8_SCHED;
            PG8_LDB(B1, 0, 1); PG8_STAGE(PG8_SB(0, 0), b2, voffB);
            PG8_BAR; PG8_WAIT_L(0); PG8_MMA(0, 1, At, B1); PG8_BAR;
            PG8_LDA(At, 0, 1); PG8_STAGE(PG8_SA(0, 0), a2, voffA);
            PG8_BAR; PG8_WAIT_L(0); PG8_MMA(1, 0, At, B0); PG8_BAR; PG8_SCHED;
            PG8_STAGE(PG8_SB(0, 1), b2 + hstepB, voffB);
            PG8_WAIT_V(6); PG8_BAR; PG8_MMA(1, 1, At, B1); PG8_BAR;
            PG8_LDB(B0, 1, 0); PG8_SCHED; PG8_LDA(At, 1, 0); PG8_STAGE(PG8_SA(0, 1), a2 + hstepA, voffA);
            PG8_WAIT_L(8); PG8_BAR; PG8_WAIT_L(0); PG8_MMA(0, 0, At, B0); PG8_BAR; PG8_SCHED;
            PG8_LDB(B1, 1, 1); PG8_STAGE(PG8_SB(1, 0), b3, voffB);
            PG8_BAR; PG8_WAIT_L(0); PG8_MMA(0, 1, At, B1); PG8_BAR;
            PG8_LDA(At, 1, 1); PG8_STAGE(PG8_SA(1, 0), a3, voffA);
            PG8_BAR; PG8_WAIT_L(0); PG8_MMA(1, 0, At, B0); PG8_BAR; PG8_SCHED;
            PG8_STAGE(PG8_SB(1, 1), b3 + hstepB, voffB);
            PG8_WAIT_V(6); PG8_BAR; PG8_MMA(1, 1, At, B1); PG8_BAR;
            }
        }
        if constexpr (ALIGN_EPI) { if (wr == 0) PG8_BAR; }
        if constexpr (!Epi::AFTER_DRAIN) { E(acc, cur, wr, wc, fr, fq); S.done(cur); }
        if (!has_next) break;
#pragma unroll
        for (int a = 0; a < 2; ++a)
#pragma unroll
            for (int b = 0; b < 2; ++b)
#pragma unroll
                for (int m = 0; m < 4; ++m)
#pragma unroll
                    for (int n = 0; n < 2; ++n) acc[a][b][m][n] = (f32x4){0.f, 0.f, 0.f, 0.f};
        cur = nxt; cA = nA; cB = nB; ++ui;
        if constexpr (ALIGN_EPI) { if (wr == 1) PG8_BAR; }
    }
    PG8_WAIT_V(0);
    if constexpr (!ALIGN_EPI) { if (wr == 0) PG8_BAR; }
    PG8_BAR;
    if constexpr (Epi::AFTER_DRAIN) { E.fused(acc, cur, wr, wc, fr, fq, lds, wid, lane); S.done(cur); }
#undef PG8_SA
#undef PG8_SB
#undef PG8_STAGE
#undef PG8_LDA
#undef PG8_LDB
#undef PG8_MMA
#undef PG8_WAIT_V
#undef PG8_WAIT_L
#undef PG8_BAR
#undef PG8_SCHED
}}

struct SchedStd {
    pg8::StaticOrder so; const char* A; const char* B; size_t tA, tB, bstride; int bshift;
    __device__ __forceinline__ void init(const void* A_, int lda, const void* B_, int ldb, int M, int N, int G, int c, int bshift_ = 30, size_t bstride_ = 0) {
        so.init(M, N, G, c); A = (const char*)A_; B = (const char*)B_; tA = (size_t)256 * lda * 2; tB = (size_t)256 * ldb * 2; bshift = bshift_; bstride = bstride_; }
    __device__ __forceinline__ bool next(int i, pg8::Unit& u) const { if (!so.next(i, u)) return false; u.a = A + (size_t)u.pm * tA; u.b = B + (size_t)u.pn * tB + (size_t)(u.pm >> bshift) * bstride; return true; }
    __device__ __forceinline__ void a_ready(const pg8::Unit&) const {}
    __device__ __forceinline__ void done(const pg8::Unit&) const {}
};
struct SchedMt {
    int G, c; const char* KV; const char* WqS;
    __device__ __forceinline__ bool next(int i, pg8::Unit& u) const { const int L = i * G + c; if (L >= 128) return false; const int b = L >> 4, h = (L >> 2) & 3, pn = L & 3;
        u.pm = b * 4 + h; u.pn = pn; u.a = KV + ((size_t)(b * 256) * 2048 + h * 256) * 2; u.b = WqS + ((size_t)pn * 256 * 1024 + h * 256) * 2; return true; }
    __device__ __forceinline__ void a_ready(const pg8::Unit&) const {}
    __device__ __forceinline__ void done(const pg8::Unit&) const {}
};
struct SchedNt {
    int G, c; const char* KV; const char* WoT;
    __device__ __forceinline__ bool next(int i, pg8::Unit& u) const { const int L = i * G + ((c + G / 2) % G); if (L >= 128) return false; const int b = L >> 4, pmc = (L >> 2) & 3, h = L & 3;
        u.pm = b * 4 + pmc; u.pn = h; u.a = WoT + ((size_t)pmc * 256 * 1024 + h * 256) * 2; u.b = KV + ((size_t)(b * 256) * 2048 + 1024 + h * 256) * 2; return true; }
    __device__ __forceinline__ void a_ready(const pg8::Unit&) const {}
    __device__ __forceinline__ void done(const pg8::Unit&) const {}
};

constexpr int NB = 8, SEQ = 4096, DM = 1024, MTOK = NB * SEQ, MEMLEN = 256, MMEM = NB * MEMLEN, INC = 3072, FF = 4096, AW = 512;
constexpr float EPS = 1e-6f, LOG2E = 1.4426950408889634f;
constexpr int NWAVES = 8;
constexpr size_t MiB = 1u << 20;
constexpr size_t WS_WIN = 1 * MiB, WS_WOUT = 7 * MiB, WS_WQS = 9 * MiB, WS_WKV = 11 * MiB, WS_WO = 15 * MiB, WS_WUP = 17 * MiB, WS_WDN = 25 * MiB;
constexpr size_t WS_MEMN = 33 * MiB, WS_KV = 37 * MiB, WS_MT = 45 * MiB, WS_NT = 61 * MiB, WS_SS1 = 77 * MiB, WS_SS2 = 79 * MiB;
constexpr size_t WS_H1 = 96 * MiB;
constexpr size_t WS_PROJ = 160 * MiB;
constexpr size_t WS_QKV = 256 * MiB;
constexpr int CONVP = 1536;
constexpr int HIDP = 4096 + 64;
constexpr size_t WS_MRG = 358 * MiB;
constexpr size_t WS_HID = 96 * MiB;
constexpr size_t WS_LSE = 82 * MiB;
constexpr size_t WS_OP01 = 96 * MiB;
constexpr size_t WS_OP2 = 422 * MiB;
constexpr size_t WS_END = 454 * MiB;
static_assert(WS_HID + (size_t)MTOK * HIDP * 2 <= WS_MRG && WS_MRG + (size_t)MTOK * 1024 * 2 <= WS_OP2 && WS_OP2 + (size_t)MTOK * AW * 2 <= WS_END, "d_ws map");
constexpr int RING_BYTES = 131072, XCH_OFF = RING_BYTES, LDS_BYTES = RING_BYTES + 8192 + 4096;

#define LAS __attribute__((address_space(3)))
typedef unsigned short bf16;
typedef float f32x4 __attribute__((ext_vector_type(4)));
typedef unsigned u32x4 __attribute__((ext_vector_type(4)));
typedef unsigned u32x2 __attribute__((ext_vector_type(2)));
#define LDS_WAIT() asm volatile("s_waitcnt lgkmcnt(0)" ::: "memory")
__device__ __forceinline__ unsigned f2bf(float f) { unsigned u = __builtin_bit_cast(unsigned, f); return (u + 0x7fffu + ((u >> 16) & 1u)) >> 16; }
__device__ __forceinline__ unsigned pk2(float lo, float hi) { return f2bf(lo) | (f2bf(hi) << 16); }
__device__ __forceinline__ float bf2f(unsigned v) { return __uint_as_float(v << 16); }
__device__ __forceinline__ float wave_sum(float v) {
#pragma unroll
    for (int o = 1; o < 64; o <<= 1) v += __shfl_xor(v, o);
    return v;
}

__device__ __forceinline__ void p0_transpose_item(const float* W, int K, int N, bf16* WT, const float* gain, LAS float* scr, int item, int lane) {
    const int nblk = N / 32, kb = item / nblk, nb = item % nblk, k0 = 64 * kb, n0 = 32 * nb;
    f32x4 v[8];
#pragma unroll
    for (int i = 0; i < 8; ++i) v[i] = __builtin_nontemporal_load((const f32x4*)(W + (size_t)(k0 + 8 * i + (lane >> 3)) * N + n0 + 4 * (lane & 7)));
#pragma unroll
    for (int i = 0; i < 8; ++i) { const int kk = 8 * i + (lane >> 3); const float g = gain ? gain[k0 + kk] : 1.0f; LAS float* d = scr + kk * 33 + 4 * (lane & 7);
        d[0] = v[i][0] * g; d[1] = v[i][1] * g; d[2] = v[i][2] * g; d[3] = v[i][3] * g; }
    LDS_WAIT(); asm volatile("" ::: "memory");
    const int c = lane & 7;
#pragma unroll
    for (int j = 0; j < 4; ++j) { const int n = (lane >> 3) + 8 * j; const LAS float* s = scr + (8 * c) * 33 + n;
        u32x4 o; o.x = pk2(s[0 * 33], s[1 * 33]); o.y = pk2(s[2 * 33], s[3 * 33]); o.z = pk2(s[4 * 33], s[5 * 33]); o.w = pk2(s[6 * 33], s[7 * 33]);
        *(u32x4*)(WT + (size_t)(n0 + n) * K + k0 + 8 * c) = o; }
    LDS_WAIT(); asm volatile("" ::: "memory");
}
__device__ __forceinline__ void rms_row_to_bf16(const float* xrow, const float* g, bf16* orow, int lane) {
    const f32x4* xr = (const f32x4*)xrow + lane; const f32x4* gr = (const f32x4*)g + lane;
    f32x4 v[4]; float s = 0.f;
#pragma unroll
    for (int j = 0; j < 4; ++j) { v[j] = xr[64 * j]; s += (v[j][0] * v[j][0] + v[j][1] * v[j][1]) + (v[j][2] * v[j][2] + v[j][3] * v[j][3]); }
    const float rs = 1.0f / sqrtf(wave_sum(s) * (1.0f / 1024.0f) + EPS);
    u32x2* o8 = (u32x2*)orow + lane;
#pragma unroll
    for (int j = 0; j < 4; ++j) { const f32x4 gv = gr[64 * j]; u32x2 o; o.x = pk2(v[j][0] * rs * gv[0], v[j][1] * rs * gv[1]); o.y = pk2(v[j][2] * rs * gv[2], v[j][3] * rs * gv[3]); o8[64 * j] = o; }
}

struct Args { const float* in[17]; float* out; unsigned char* ws; int ph_lo, ph_hi; };
enum { I_X = 0, I_MEM, I_GMIX, I_WIN, I_CONVW, I_GATT, I_GCONV, I_WOUT, I_GX, I_GMEM, I_WQ, I_WKV, I_WO, I_GMLP, I_WUP, I_WDN, I_GFIN };

__device__ __forceinline__ void p0_rows(const Args& a, int gw, int NGW, int lane) {
    const float* X = a.in[I_X]; const float* g = a.in[I_GMIX]; bf16* H1 = (bf16*)(a.ws + WS_H1);
    const f32x4* gr = (const f32x4*)g + lane;
#pragma unroll 1
    for (int m = gw; m < MTOK; m += 2 * NGW) {
        const int m2 = m + NGW; const bool has2 = m2 < MTOK;
        const f32x4* x0 = (const f32x4*)(X + (size_t)m * 1024) + lane; const f32x4* x1 = (const f32x4*)(X + (size_t)(has2 ? m2 : m) * 1024) + lane;
        f32x4 v[4], w[4]; float s0 = 0.f, s1 = 0.f;
#pragma unroll
        for (int j = 0; j < 4; ++j) { v[j] = __builtin_nontemporal_load(x0 + 64 * j); w[j] = __builtin_nontemporal_load(x1 + 64 * j); }
#pragma unroll
        for (int j = 0; j < 4; ++j) { s0 += (v[j][0] * v[j][0] + v[j][1] * v[j][1]) + (v[j][2] * v[j][2] + v[j][3] * v[j][3]); s1 += (w[j][0] * w[j][0] + w[j][1] * w[j][1]) + (w[j][2] * w[j][2] + w[j][3] * w[j][3]); }
#pragma unroll
        for (int o = 1; o < 64; o <<= 1) { s0 += __shfl_xor(s0, o); s1 += __shfl_xor(s1, o); }
        const float r0 = 1.0f / sqrtf(s0 * (1.0f / 1024.0f) + EPS), r1 = 1.0f / sqrtf(s1 * (1.0f / 1024.0f) + EPS);
        u32x2* o0 = (u32x2*)(H1 + (size_t)m * 1024) + lane; u32x2* o1 = (u32x2*)(H1 + (size_t)m2 * 1024) + lane;
#pragma unroll
        for (int j = 0; j < 4; ++j) { const f32x4 gv = gr[64 * j]; u32x2 o; o.x = pk2(v[j][0] * r0 * gv[0], v[j][1] * r0 * gv[1]); o.y = pk2(v[j][2] * r0 * gv[2], v[j][3] * r0 * gv[3]); o0[64 * j] = o;
            if (has2) { u32x2 p; p.x = pk2(w[j][0] * r1 * gv[0], w[j][1] * r1 * gv[1]); p.y = pk2(w[j][2] * r1 * gv[2], w[j][3] * r1 * gv[3]); o1[64 * j] = p; } }
    }
}
__device__ __forceinline__ void p0_prologue(const Args& a, LAS unsigned char* lds, int gw, int NGW, int wave, int lane) {
    unsigned char* ws = a.ws;
    LAS float* scr = (LAS float*)(lds + wave * 16384);
    constexpr int I_IN = 16 * 96, I_OUT = 16 * 32, I_KV = 16 * 64, I_O = 16 * 32, I_UP = 16 * 128, I_DN = 64 * 32;
    constexpr int NITEMS = I_IN + I_OUT + I_KV + I_O + I_UP + I_DN;
    const bool rows_first = (wave & 1) != 0;
    if (rows_first) p0_rows(a, gw, NGW, lane);
    for (int it = gw; it < NITEMS; it += NGW) {
        int r = it;
        if (r < I_IN) { p0_transpose_item(a.in[I_WIN], 1024, 3072, (bf16*)(ws + WS_WIN), nullptr, scr, r, lane); continue; } r -= I_IN;
        if (r < I_OUT) { p0_transpose_item(a.in[I_WOUT], 1024, 1024, (bf16*)(ws + WS_WOUT), nullptr, scr, r, lane); continue; } r -= I_OUT;
        if (r < I_KV) { p0_transpose_item(a.in[I_WKV], 1024, 2048, (bf16*)(ws + WS_WKV), nullptr, scr, r, lane); continue; } r -= I_KV;
        if (r < I_O) { p0_transpose_item(a.in[I_WO], 1024, 1024, (bf16*)(ws + WS_WO), nullptr, scr, r, lane); continue; } r -= I_O;
        if (r < I_UP) { p0_transpose_item(a.in[I_WUP], 1024, 4096, (bf16*)(ws + WS_WUP), a.in[I_GMLP], scr, r, lane); continue; } r -= I_UP;
        p0_transpose_item(a.in[I_WDN], 4096, 1024, (bf16*)(ws + WS_WDN), nullptr, scr, r, lane);
    }
    for (int c = gw; c < 1024; c += NGW) { const float g = a.in[I_GX][c]; const f32x4* wr_ = (const f32x4*)(a.in[I_WQ] + (size_t)c * 1024) + lane; u32x2* o8 = (u32x2*)((bf16*)(ws + WS_WQS) + (size_t)c * 1024) + lane;
#pragma unroll
        for (int j = 0; j < 4; ++j) { const f32x4 v = wr_[64 * j]; u32x2 o; o.x = pk2(v[0] * g, v[1] * g); o.y = pk2(v[2] * g, v[3] * g); o8[64 * j] = o; } }
    for (int m = gw; m < MMEM; m += NGW) rms_row_to_bf16(a.in[I_MEM] + (size_t)m * 1024, a.in[I_GMEM], (bf16*)(ws + WS_MEMN) + (size_t)m * 1024, lane);
    if (!rows_first) p0_rows(a, gw, NGW, lane);
}

__device__ __forceinline__ void unpack8(const u32x4 w, float (&f)[8]) {
#pragma unroll
    for (int i = 0; i < 4; ++i) { f[2 * i] = __uint_as_float(w[i] << 16); f[2 * i + 1] = __uint_as_float(w[i] & 0xffff0000u); }
}
typedef float f32x16 __attribute__((ext_vector_type(16)));
typedef short bf16x8 __attribute__((ext_vector_type(8)));
typedef short s16x4 __attribute__((ext_vector_type(4)));
__device__ __forceinline__ float swap32_max(float v) { auto rr = __builtin_amdgcn_permlane32_swap(__float_as_uint(v), __float_as_uint(v), false, false); return fmaxf(__uint_as_float(rr[0]), __uint_as_float(rr[1])); }
__device__ __forceinline__ float swap32_sum(float v) { auto rr = __builtin_amdgcn_permlane32_swap(__float_as_uint(v), __float_as_uint(v), false, false); return __uint_as_float(rr[0]) + __uint_as_float(rr[1]); }
__device__ __forceinline__ s16x4 vtr(const LAS unsigned char* p) { return __builtin_bit_cast(s16x4, __builtin_amdgcn_ds_read_tr16_b64_v4i16((LAS s16x4*)p)); }
__device__ __forceinline__ bf16x8 packp(const f32x16& p, int b) { u32x4 w; w.x = pg8::cvt_pk_bf16(p[b], p[b + 1]); w.y = pg8::cvt_pk_bf16(p[b + 2], p[b + 3]); w.z = pg8::cvt_pk_bf16(p[b + 4], p[b + 5]); w.w = pg8::cvt_pk_bf16(p[b + 6], p[b + 7]); return __builtin_bit_cast(bf16x8, w); }

constexpr int P2_UNITS = 3072, P2_KIMG = 0, P2_VIMG = 49152, P2_STAGE = 98304;
struct P2Unit { const bf16* pb; int h, p, dil, r, m0; size_t tokbase; };
__device__ __forceinline__ P2Unit p2_decode(int L, const bf16* proj) {
    P2Unit u; const int xcd = L & 7, idx = L >> 3, b = idx / 48, rem = idx % 48, uu = rem & 15; u.p = rem >> 4; u.h = xcd;
    const int dsh = 2 * u.p; u.dil = 1 << dsh; const int chunk = uu & ((16 >> dsh) - 1); u.r = uu >> (4 - dsh); u.m0 = chunk * 256;
    u.pb = proj + (size_t)(b * 8 + u.h) * SEQ * 64; u.tokbase = (size_t)b * SEQ; return u;
}
constexpr size_t QKV_PLANE = (size_t)MTOK * AW;
__device__ __forceinline__ void p2a_attn(const bf16* proj, bf16* op01, bf16* op2, float* lse, LAS unsigned char* lds, int G, int bx, int wave, int tid) {
    const int lane = tid & 63, r32 = lane & 31, hi = lane >> 5;
    const int vr_off = (4 * hi + ((lane & 15) >> 2)) * 64 + ((lane >> 4) & 1) * 32 + (lane & 3) * 8;
    u32x4 kreg[6], vreg[6], qn[4];
    LAS unsigned char* stage = lds + P2_STAGE + wave * 4096;
#define P2A_ISSUE(LL) do { const P2Unit un = p2_decode((LL), proj); \
        _Pragma("unroll") for (int j = 0; j < 4; ++j) { const int row = (lane >> 3) + 8 * j; \
          qn[j] = *(const u32x4*)(un.pb + (size_t)((un.m0 + 32 * wave + row) * un.dil + un.r) * 64 + (lane & 7) * 8); } \
        _Pragma("unroll") for (int j = 0; j < 6; ++j) { const int q = tid + 512 * j, row = q >> 3, ch = q & 7; const int pos = max(un.m0 - 128 + row, 0); \
          const bf16* kp = un.pb + QKV_PLANE + (size_t)(pos * un.dil + un.r) * 64 + ch * 8; kreg[j] = *(const u32x4*)kp; vreg[j] = *(const u32x4*)(kp + QKV_PLANE); } } while (0)
    const int xcd_ = bx & 7, cl = bx >> 3;
    const bool g256 = (G == 256);
    const int ncl = g256 ? 32 : (G + 7 - xcd_) / 8;
    const int cnt = g256 ? (cl < 8 ? 9 : 13) : (384 - cl + ncl - 1) / ncl;
#define P2A_IDX(k) ((g256 && (k) >= 9) ? 288 + 24 * ((k) - 9) + (cl - 8) : ncl * (k) + cl)
    if (cnt > 0) P2A_ISSUE(P2A_IDX(0) * 8 + xcd_);
#pragma unroll 1
    for (int k = 0; k < cnt; ++k) {
        const int L = P2A_IDX(k) * 8 + xcd_;
        const P2Unit u = p2_decode(L, proj);
        __syncthreads();
#pragma unroll
        for (int j = 0; j < 6; ++j) { const int q = tid + 512 * j, row = q >> 3, ch = q & 7;
            *(LAS u32x4*)(lds + P2_KIMG + row * 128 + ((ch ^ (row & 7)) * 16)) = kreg[j];
            *(LAS u32x4*)(lds + P2_VIMG + (row >> 5) * 4096 + (ch >> 2) * 2048 + (row & 31) * 64 + (ch & 3) * 16) = vreg[j]; }
#pragma unroll
        for (int j = 0; j < 4; ++j) { const int row = (lane >> 3) + 8 * j; *(LAS u32x4*)(stage + row * 128 + (((lane & 7) ^ (row & 7)) * 16)) = qn[j]; }
        asm volatile("" ::: "memory");
        bf16x8 qf[4];
#pragma unroll
        for (int d0 = 0; d0 < 4; ++d0) qf[d0] = *(const LAS bf16x8*)(stage + r32 * 128 + (((2 * d0 + hi) ^ (r32 & 7)) * 16));
        __syncthreads();
        if (k + 1 < cnt) P2A_ISSUE(P2A_IDX(k + 1) * 8 + xcd_);
        f32x16 pt[5];
#pragma unroll
        for (int j = 0; j < 5; ++j) {
            const int kt = wave + j;
            const LAS unsigned char* kb = lds + P2_KIMG + kt * 4096 + r32 * 128;
#pragma unroll
            for (int i = 0; i < 16; ++i) pt[j][i] = 0.f;
            bf16x8 kf[4];
#pragma unroll
            for (int d0 = 0; d0 < 4; ++d0) kf[d0] = *(const LAS bf16x8*)(kb + (((2 * d0 + hi) ^ (r32 & 7)) * 16));
#pragma unroll
            for (int d0 = 0; d0 < 4; ++d0) pt[j] = __builtin_amdgcn_mfma_f32_32x32x16_bf16(kf[d0], qf[d0], pt[j], 0, 0, 0);
        }
        const int ntv = min(5, max(0, (u.m0 + 32 * wave) / 32 + 1));
#pragma unroll
        for (int j = 0; j < 4; ++j) { const bool ok = (5 - j) <= ntv;
#pragma unroll
            for (int i = 0; i < 16; ++i) pt[j][i] = ok ? pt[j][i] : -1.0e30f; }
#pragma unroll
        for (int i = 0; i < 16; ++i) { const int kk = (i & 3) + 8 * (i >> 2) + 4 * hi;
            pt[0][i] = (kk >= r32) ? pt[0][i] : -1.0e30f;
            pt[4][i] = (kk <= r32) ? pt[4][i] : -1.0e30f; }
        float mxa = fmaxf(pt[0][0], pt[1][0]), mxb = fmaxf(pt[2][0], pt[3][0]), mxc = pt[4][0];
#pragma unroll
        for (int i = 1; i < 16; ++i) { mxa = fmaxf(mxa, fmaxf(pt[0][i], pt[1][i])); mxb = fmaxf(mxb, fmaxf(pt[2][i], pt[3][i])); mxc = fmaxf(mxc, pt[4][i]); }
        const float m_run = swap32_max(fmaxf(fmaxf(mxa, mxb), mxc));
        float la = 0.f, lb = 0.f;
#pragma unroll
        for (int j = 0; j < 5; ++j)
#pragma unroll
            for (int i = 0; i < 16; i += 2) { pt[j][i] = __builtin_amdgcn_exp2f(pt[j][i] - m_run); pt[j][i + 1] = __builtin_amdgcn_exp2f(pt[j][i + 1] - m_run); la += pt[j][i]; lb += pt[j][i + 1]; }
        float l = la + lb;
        f32x16 o0, o1;
#pragma unroll
        for (int i = 0; i < 16; ++i) { o0[i] = 0.f; o1[i] = 0.f; }
#pragma unroll
        for (int j = 0; j < 5; ++j) {
            const int kt = wave + j;
            const bf16x8 pf0 = packp(pt[j], 0), pf1 = packp(pt[j], 8);
            const LAS unsigned char* vb = lds + P2_VIMG + kt * 4096 + vr_off;
#pragma unroll
            for (int ks = 0; ks < 2; ++ks) {
                const s16x4 a0 = vtr(vb + ks * 1024), a1 = vtr(vb + ks * 1024 + 512), b0 = vtr(vb + 2048 + ks * 1024), b1 = vtr(vb + 2048 + ks * 1024 + 512);
                const bf16x8 v0 = {a0[0], a0[1], a0[2], a0[3], a1[0], a1[1], a1[2], a1[3]}, v1 = {b0[0], b0[1], b0[2], b0[3], b1[0], b1[1], b1[2], b1[3]};
                o0 = __builtin_amdgcn_mfma_f32_32x32x16_bf16(v0, ks ? pf1 : pf0, o0, 0, 0, 0);
                o1 = __builtin_amdgcn_mfma_f32_32x32x16_bf16(v1, ks ? pf1 : pf0, o1, 0, 0, 0);
            }
        }
        l = swap32_sum(l);
        const float inv = 1.0f / l;
        const size_t token = u.tokbase + (size_t)(u.m0 + 32 * wave + r32) * u.dil + u.r;
        bf16* obase = (u.p == 2 ? op2 : op01 + (size_t)u.p * MTOK * AW) + u.h * 64 + (lane & 7) * 8;
#pragma unroll
        for (int g4 = 0; g4 < 4; ++g4) {
            u32x2 wa, wb;
            wa.x = pg8::cvt_pk_bf16(o0[4 * g4] * inv, o0[4 * g4 + 1] * inv); wa.y = pg8::cvt_pk_bf16(o0[4 * g4 + 2] * inv, o0[4 * g4 + 3] * inv);
            wb.x = pg8::cvt_pk_bf16(o1[4 * g4] * inv, o1[4 * g4 + 1] * inv); wb.y = pg8::cvt_pk_bf16(o1[4 * g4 + 2] * inv, o1[4 * g4 + 3] * inv);
            *(LAS u32x2*)(stage + r32 * 128 + ((g4 ^ (r32 & 7)) * 16) + 8 * hi) = wa;
            *(LAS u32x2*)(stage + r32 * 128 + (((4 + g4) ^ (r32 & 7)) * 16) + 8 * hi) = wb;
        }
        asm volatile("" ::: "memory");
#pragma unroll
        for (int j = 0; j < 4; ++j) { const int row = (lane >> 3) + 8 * j;
            const u32x4 v = *(const LAS u32x4*)(stage + row * 128 + (((lane & 7) ^ (row & 7)) * 16));
            *(u32x4*)(obase + (u.tokbase + (size_t)(u.m0 + 32 * wave + row) * u.dil + u.r) * AW) = v; }
        if (hi == 0) lse[((size_t)u.p * MTOK + token) * 8 + u.h] = m_run + __builtin_amdgcn_logf(l);
    }
#undef P2A_ISSUE
#undef P2A_IDX
}
struct P3Tok { float l0, l1, l2; u32x4 a0, a1, a2, bg, cg0, xc0, cg1, xc1, cg2, xc2; };
__device__ __forceinline__ void p3_load(P3Tok& k, const bf16* proj, const bf16* op01, const bf16* op2, const float* lse, int token, int lane) {
    const int hh = lane >> 3, c0 = 8 * lane, t = token & (SEQ - 1); const bf16* prow = proj + (size_t)token * CONVP; const u32x4 z = {0u, 0u, 0u, 0u};
    k.l0 = __builtin_nontemporal_load(lse + (size_t)token * 8 + hh); k.l1 = __builtin_nontemporal_load(lse + ((size_t)MTOK + token) * 8 + hh); k.l2 = __builtin_nontemporal_load(lse + ((size_t)2 * MTOK + token) * 8 + hh);
    k.a0 = __builtin_nontemporal_load((const u32x4*)(op01 + (size_t)token * AW + c0)); k.a1 = __builtin_nontemporal_load((const u32x4*)(op01 + ((size_t)MTOK + token) * AW + c0)); k.a2 = __builtin_nontemporal_load((const u32x4*)(op2 + (size_t)token * AW + c0));
    k.bg = *(const u32x4*)(prow + c0); k.cg0 = *(const u32x4*)(prow + 512 + c0); k.xc0 = *(const u32x4*)(prow + 1024 + c0);
    k.cg1 = t >= 1 ? *(const u32x4*)(prow - CONVP + 512 + c0) : z; k.xc1 = t >= 1 ? *(const u32x4*)(prow - CONVP + 1024 + c0) : z;
    k.cg2 = t >= 2 ? *(const u32x4*)(prow - 2 * CONVP + 512 + c0) : z; k.xc2 = t >= 2 ? *(const u32x4*)(prow - 2 * CONVP + 1024 + c0) : z;
}
__device__ __forceinline__ void p3_compute(const P3Tok& k, const float* conv_w, const float* g_a, const float* g_c, bf16* merged, int token, int lane) {
    const int c0 = 8 * lane;
    const float mx = fmaxf(k.l0, fmaxf(k.l1, k.l2));
    float w0 = __builtin_amdgcn_exp2f(k.l0 - mx), w1 = __builtin_amdgcn_exp2f(k.l1 - mx), w2 = __builtin_amdgcn_exp2f(k.l2 - mx);
    const float winv = 1.0f / (w0 + w1 + w2); w0 *= winv; w1 *= winv; w2 *= winv;
    float a0[8], a1[8], a2[8], bg[8], cg0[8], xc0[8], cg1[8], xc1[8], cg2[8], xc2[8];
    unpack8(k.a0, a0); unpack8(k.a1, a1); unpack8(k.a2, a2); unpack8(k.bg, bg); unpack8(k.cg0, cg0); unpack8(k.xc0, xc0); unpack8(k.cg1, cg1); unpack8(k.xc1, xc1); unpack8(k.cg2, cg2); unpack8(k.xc2, xc2);
    float y[8], yc[8]; float ss = 0.f, sc = 0.f;
#pragma unroll
    for (int e = 0; e < 8; ++e) { y[e] = w0 * a0[e] + w1 * a1[e] + w2 * a2[e]; ss += y[e] * y[e];
        const float cw0 = conv_w[c0 + e], cw1 = conv_w[512 + c0 + e], cw2 = conv_w[1024 + c0 + e];
        yc[e] = bg[e] * (cw0 * (cg2[e] * xc2[e]) + cw1 * (cg1[e] * xc1[e]) + cw2 * (cg0[e] * xc0[e])); sc += yc[e] * yc[e]; }
#pragma unroll
    for (int o = 1; o < 64; o <<= 1) { ss += __shfl_xor(ss, o); sc += __shfl_xor(sc, o); }
    const float rs = 1.0f / sqrtf(ss * (1.0f / 512.0f) + EPS), rc = 1.0f / sqrtf(sc * (1.0f / 512.0f) + EPS);
    u32x4 o, oc;
#pragma unroll
    for (int i = 0; i < 4; ++i) { o[i] = pk2(y[2 * i] * rs * g_a[c0 + 2 * i], y[2 * i + 1] * rs * g_a[c0 + 2 * i + 1]); oc[i] = pk2(yc[2 * i] * rc * g_c[c0 + 2 * i], yc[2 * i + 1] * rc * g_c[c0 + 2 * i + 1]); }
    *(u32x4*)(merged + (size_t)token * 1024 + c0) = o; *(u32x4*)(merged + (size_t)token * 1024 + 512 + c0) = oc;
}
__device__ __forceinline__ void p3_merge(const bf16* proj, const bf16* op01, const bf16* op2, const float* lse, const float* conv_w, const float* g_a, const float* g_c, bf16* merged, int gw, int NGW, int lane) {
#pragma unroll 1
    for (int token = gw; token < MTOK; token += 2 * NGW) {
        const int tok2 = token + NGW; const bool has2 = tok2 < MTOK;
        P3Tok k0, k1;
        p3_load(k0, proj, op01, op2, lse, token, lane); p3_load(k1, proj, op01, op2, lse, has2 ? tok2 : token, lane);
        p3_compute(k0, conv_w, g_a, g_c, merged, token, lane);
        if (has2) p3_compute(k1, conv_w, g_a, g_c, merged, tok2, lane);
    }
}
__device__ __forceinline__ void p8_final(float* out, const float* g, int gw, int NGW, int lane) {
    for (int m = gw; m < MTOK; m += NGW) {
        f32x4* xr = (f32x4*)(out + (size_t)m * 1024) + lane; const f32x4* gr = (const f32x4*)g + lane;
        f32x4 v[4]; float s = 0.f;
#pragma unroll
        for (int j = 0; j < 4; ++j) { v[j] = xr[64 * j]; s += (v[j][0] * v[j][0] + v[j][1] * v[j][1]) + (v[j][2] * v[j][2] + v[j][3] * v[j][3]); }
        const float rs = 1.0f / sqrtf(wave_sum(s) * (1.0f / 1024.0f) + EPS);
#pragma unroll
        for (int j = 0; j < 4; ++j) xr[64 * j] = v[j] * rs * gr[64 * j];
    }
}

#define RLX_AGENT __ATOMIC_RELAXED, __HIP_MEMORY_SCOPE_AGENT
#define XB_TMO      128
#define XB_XCNT(j)  (256  + 64 * (j))
#define XB_XSUB(j)  (1280 + 64 * (j))
#define XB_XGEN(j)  (2304 + 64 * (j))
#define XB_TOP      3328
#define XB_TOPGEN   3392
#define XCD_BAR_WORDS 3456
#define XB_SPIN_CAP (1u << 18)

__device__ __forceinline__ unsigned xb_ld(unsigned* p)              { return __hip_atomic_load(p, __ATOMIC_RELAXED, __HIP_MEMORY_SCOPE_AGENT); }
__device__ __forceinline__ unsigned xb_add(unsigned* p, unsigned v) { return __hip_atomic_fetch_add(p, v, __ATOMIC_RELAXED, __HIP_MEMORY_SCOPE_AGENT); }
__device__ __forceinline__ unsigned xb_xcc_id() { return (unsigned)__builtin_amdgcn_s_getreg((3 << 11) | 20) & 0xFu; }
#define XB_SPIN(cond, bar) do { unsigned _sp = 0; while (cond) { __builtin_amdgcn_s_sleep(1); \
    if ((++_sp & 255u) == 0u) { if (xb_ld(&(bar)[XB_TMO])) break; if (_sp > XB_SPIN_CAP) { atomicAdd(&(bar)[XB_TMO], 1u); break; } } } } while (0)

struct XcdBarrier {
    unsigned* bar; unsigned x;
    volatile LAS unsigned* st;
};

__device__ __forceinline__ XcdBarrier xcd_barrier_post(unsigned* bar, volatile LAS unsigned* st) {
    XcdBarrier b; b.bar = bar; b.x = xb_xcc_id(); b.st = st;
    if (threadIdx.x == 0) (void)xb_add(&bar[XB_XCNT(b.x)], 1u);
    return b;
}
__device__ __forceinline__ void xcd_barrier_complete(unsigned* bar, unsigned x, unsigned& nloc, unsigned& nx) {
    const unsigned G = gridDim.x * gridDim.y * gridDim.z;
    unsigned sum, cnt, mine, sp = 0u;
    for (;;) {
        sum = 0u; cnt = 0u; mine = 0u;
#pragma unroll
        for (unsigned j = 0; j < 16; ++j) { const unsigned c = xb_ld(&bar[XB_XCNT(j)]); sum += c; cnt += (c > 0u) ? 1u : 0u; mine = (j == x) ? c : mine; }
        if (sum == G) break;
        __builtin_amdgcn_s_sleep(1);
        if ((++sp & 255u) == 0u) { if (xb_ld(&bar[XB_TMO])) break; if (sp > XB_SPIN_CAP) { atomicAdd(&bar[XB_TMO], 1u); break; } }
    }
    nloc = mine > 0u ? mine : 1u; nx = cnt > 0u ? cnt : 1u;
}

__device__ __forceinline__ void xcd_barrier(const XcdBarrier& b) {
    asm volatile("s_waitcnt vmcnt(0)" ::: "memory");
    __syncthreads();
    if (threadIdx.x == 0) {
        unsigned* bar = b.bar;
        __builtin_amdgcn_s_waitcnt(0);
        unsigned nloc = b.st[0], nx = b.st[1];
        if (nloc == 0u) { xcd_barrier_complete(bar, b.x, nloc, nx); b.st[0] = nloc; b.st[1] = nx; }
        const unsigned old = xb_add(&bar[XB_XSUB(b.x)], 1u);
        const unsigned gen = old / nloc;
        if (old + 1u == (gen + 1u) * nloc) {
            __builtin_amdgcn_fence(__ATOMIC_RELEASE, "agent");
            asm volatile("s_waitcnt vmcnt(0)" ::: "memory");
            const unsigned og = xb_add(&bar[XB_TOP], 1u);
            const unsigned tg = og / nx;
            if (og + 1u == (tg + 1u) * nx) xb_add(&bar[XB_TOPGEN], 1u);
            else XB_SPIN(xb_ld(&bar[XB_TOPGEN]) == tg, bar);
            __builtin_amdgcn_fence(__ATOMIC_ACQUIRE, "agent");
            xb_add(&bar[XB_XGEN(b.x)], 1u);
            asm volatile("s_waitcnt vmcnt(0)" ::: "memory");
        } else {
            XB_SPIN(xb_ld(&bar[XB_XGEN(b.x)]) == gen, bar);
            __builtin_amdgcn_fence(__ATOMIC_ACQUIRE, "agent");
            asm volatile("s_waitcnt vmcnt(0)" ::: "memory");
        }
    }
    __syncthreads();
}
constexpr int NPHASE = 10;
constexpr int CW_PANEL = 4096;
#ifndef DUP_PHASE
#define DUP_PHASE -1
#endif
#define NREP(k) ((k) == DUP_PHASE ? 2 : 1)
__global__ void __launch_bounds__(NWAVES * 64, 2) mega(Args a) {
    extern __shared__ __attribute__((aligned(16))) unsigned char lds_raw[];
    LAS unsigned char* lds = (LAS unsigned char*)lds_raw;
    const int wave = __builtin_amdgcn_readfirstlane((int)threadIdx.x >> 6);
#define LANE() ({ int t_ = threadIdx.x; asm volatile("" : "+v"(t_)); t_ & 63; })
    const int G = gridDim.x, bx = blockIdx.x;
    const int gw = bx * NWAVES + wave, NGW = G * NWAVES;
    unsigned char* ws = a.ws;
    const int lo = a.ph_lo, hi = a.ph_hi;
    if (lo < 0) cg::this_grid().sync();
    volatile LAS unsigned* MISC = (volatile LAS unsigned*)(lds + XCH_OFF + 8192);
    if (threadIdx.x < 64) MISC[threadIdx.x] = 0u;
    __syncthreads();
    XcdBarrier bar; bar.bar = (unsigned*)ws; bar.x = 0; bar.st = nullptr;
    if (hi - lo > 1) bar = xcd_barrier_post((unsigned*)ws, MISC + 8);
#define IN(k) (lo <= (k) && (k) < hi)
#define SEAM(k) do { if (IN(k) && IN((k) + 1)) xcd_barrier(bar); } while (0)
    bf16* const H1 = (bf16*)(ws + WS_H1); bf16* const PROJ = (bf16*)(ws + WS_PROJ); bf16* const MRG = (bf16*)(ws + WS_MRG); bf16* const HID = (bf16*)(ws + WS_HID);
    bf16* const KV = (bf16*)(ws + WS_KV); bf16* const MT = (bf16*)(ws + WS_MT); bf16* const NT = (bf16*)(ws + WS_NT);
    float* const SS1 = (float*)(ws + WS_SS1); float* const SS2 = (float*)(ws + WS_SS2);

    enum { PH_PRO = 0, PH_PROJ, PH_ATTN, PH_MERGE, PH_WOUT, PH_S, PH_PN, PH_UP, PH_DOWN, PH_FINAL };
    bf16* const QKVH = (bf16*)(ws + WS_QKV); bf16* const OP01 = (bf16*)(ws + WS_OP01); bf16* const OP2 = (bf16*)(ws + WS_OP2); float* const LSE = (float*)(ws + WS_LSE);
    if (IN(PH_PRO)) for (int rep = 0; rep < NREP(PH_PRO); ++rep) { p0_prologue(a, lds, gw, NGW, wave, LANE()); __syncthreads(); }
    SEAM(PH_PRO);
    if (IN(PH_PROJ)) for (int rep = 0; rep < NREP(PH_PROJ); ++rep) {
        { pg8::Gemm g{1024, 1024, 1024}; SchedStd S; S.init(H1, 1024, ws + WS_WIN, 1024, MTOK, INC, G, bx); pg8::EpiProj E{PROJ, QKVH, 0.125f * LOG2E};
          pg8::gemm_phase<pg8::EpiProj, SchedStd, true, true>(lds, g, S, E); }
    }
    SEAM(PH_PROJ);
    if (IN(PH_ATTN)) for (int rep = 0; rep < NREP(PH_ATTN); ++rep) {
        { pg8::Gemm g{1024, 1024, 1024}; SchedStd S; S.init(ws + WS_MEMN, 1024, ws + WS_WKV, 1024, MMEM, 2048, G, bx); pg8::EpiStore E{KV, 2048, 0, 1.0f};
          pg8::gemm_phase<pg8::EpiStore, SchedStd, true, true>(lds, g, S, E); }
        { int t_ = threadIdx.x; asm volatile("" : "+v"(t_)); p2a_attn(QKVH, OP01, OP2, LSE, lds, G, bx, wave, t_); }
    }
    SEAM(PH_ATTN);
    if (IN(PH_MERGE)) for (int rep = 0; rep < NREP(PH_MERGE); ++rep) {
        int k256 = 256; asm volatile("" : "+s"(k256));
        { pg8::Gemm g{k256, 2048, 1024}; SchedMt S{G, bx, (const char*)KV, (const char*)(ws + WS_WQS)}; pg8::EpiStore E{MT, 1024, 0, 1.0f};
          pg8::gemm_phase<pg8::EpiStore, SchedMt, true, true>(lds, g, S, E); }
        { pg8::Gemm g{k256, 1024, 2048}; SchedNt S{G, bx, (const char*)KV, (const char*)(ws + WS_WO)}; pg8::EpiStore E{NT, 1024, 0, 1.0f};
          pg8::gemm_phase<pg8::EpiStore, SchedNt, true, true>(lds, g, S, E); }
        p3_merge(PROJ, OP01, OP2, LSE, a.in[I_CONVW], a.in[I_GATT], a.in[I_GCONV], MRG, gw, NGW, LANE());
    }
    SEAM(PH_MERGE);
    if (IN(PH_WOUT)) for (int rep = 0; rep < NREP(PH_WOUT); ++rep) { pg8::Gemm g{1024, 1024, 1024}; SchedStd S; S.init(MRG, 1024, ws + WS_WOUT, 1024, MTOK, 1024, G, bx); pg8::EpiResid<false> E{a.in[I_X], nullptr, H1, SS1};
        pg8::gemm_phase<pg8::EpiResid<false>, SchedStd, false, true>(lds, g, S, E); }
    SEAM(PH_WOUT);
    if (IN(PH_S)) for (int rep = 0; rep < NREP(PH_S); ++rep) { pg8::Gemm g{1024, 1024, 1024}; SchedStd S; S.init(H1, 1024, MT, 1024, MTOK, 1024, G, bx, 4, (size_t)1024 * 1024 * 2); pg8::EpiSoftmax E{SS1, PROJ, (LAS float*)(lds + XCH_OFF)};
        pg8::gemm_phase<pg8::EpiSoftmax, SchedStd, true, true>(lds, g, S, E); }
    SEAM(PH_S);
    if (IN(PH_PN)) for (int rep = 0; rep < NREP(PH_PN); ++rep) { pg8::Gemm g{1024, 1024, 1024}; SchedStd S; S.init(PROJ, 1024, NT, 1024, MTOK, 1024, G, bx, 4, (size_t)1024 * 1024 * 2); pg8::EpiResid<true> E{H1, nullptr, MRG, SS2};
        pg8::gemm_phase<pg8::EpiResid<true>, SchedStd, true, true>(lds, g, S, E); }
    SEAM(PH_PN);
    if (IN(PH_UP)) for (int rep = 0; rep < NREP(PH_UP); ++rep) { pg8::Gemm g{1024, 1024, 1024}; SchedStd S; S.init(MRG, 1024, ws + WS_WUP, 1024, MTOK, FF, G, bx); pg8::EpiRelu2 E{SS2, HID, HIDP};
        pg8::gemm_phase<pg8::EpiRelu2, SchedStd, true, true>(lds, g, S, E); }
    SEAM(PH_UP);
    const bool fuse_final = (G == 256) && IN(PH_DOWN) && IN(PH_FINAL);
    if (IN(PH_DOWN)) for (int rep = 0; rep < NREP(PH_DOWN); ++rep) { pg8::Gemm g{4096, HIDP, 4096}; SchedStd S; S.init(HID, HIDP, ws + WS_WDN, 4096, MTOK, 1024, G, bx);
        if (fuse_final) { pg8::EpiFinal E{MRG, a.out, a.in[I_GFIN], (unsigned*)(ws + WS_SS1), (unsigned*)ws + CW_PANEL, (LAS float*)(lds + XCH_OFF)};
            pg8::gemm_phase<pg8::EpiFinal, SchedStd, true, true>(lds, g, S, E); }
        else { pg8::EpiResid<true> E{MRG, a.out, nullptr, nullptr};
            pg8::gemm_phase<pg8::EpiResid<true>, SchedStd, true, true>(lds, g, S, E); } }
    if (!fuse_final) {
        SEAM(PH_DOWN);
        if (IN(PH_FINAL)) p8_final(a.out, a.in[I_GFIN], gw, NGW, LANE());
    }
#undef IN
#undef SEAM
}

extern "C" void kernel_launch(void* const* d_in, const int* in_sizes, int n_in, void* d_out, int out_size, void* d_ws, size_t ws_size, hipStream_t stream) {
    static int grid = 0;
    if (grid == 0) {
        if (n_in != 17 || in_sizes[0] != MTOK * DM || out_size != MTOK * DM || ws_size < WS_END) { fprintf(stderr, "kernel_launch: unexpected shapes (n_in %d, in0 %d, out %d, ws %zu); nothing launched\n", n_in, n_in > 0 ? in_sizes[0] : -1, out_size, ws_size); grid = -1; return; }
        int dev = 0, cus = 0, per_cu = 0;
        if (hipGetDevice(&dev) != hipSuccess || hipDeviceGetAttribute(&cus, hipDeviceAttributeMultiprocessorCount, dev) != hipSuccess) { grid = -1; return; }
        if (hipFuncSetAttribute((const void*)mega, hipFuncAttributeMaxDynamicSharedMemorySize, LDS_BYTES) != hipSuccess) { fprintf(stderr, "kernel_launch: hipFuncSetAttribute failed\n"); grid = -1; return; }
        if (hipOccupancyMaxActiveBlocksPerMultiprocessor(&per_cu, (const void*)mega, NWAVES * 64, LDS_BYTES) != hipSuccess || per_cu < 1) { fprintf(stderr, "kernel_launch: occupancy query says %d\n", per_cu); per_cu = 1; }
        (void)hipGetLastError();
        grid = cus * per_cu;
    }
    if (grid < 0) return;
    Args a{};
    for (int i = 0; i < 17; ++i) a.in[i] = (const float*)d_in[i];
    a.out = (float*)d_out; a.ws = (unsigned char*)d_ws;
#if N_LAUNCHES == 1
    if (hipMemsetAsync(d_ws, 0, 65536, stream) != hipSuccess) { fprintf(stderr, "kernel_launch: hipMemsetAsync failed\n"); return; }
    a.ph_lo = 0; a.ph_hi = NPHASE;
    void* args[] = {&a};
    hipError_t e = hipLaunchCooperativeKernel((const void*)mega, dim3(grid), dim3(NWAVES * 64), args, LDS_BYTES, stream);
    if (e != hipSuccess) fprintf(stderr, "kernel_launch: cooperative launch failed: %s (grid %d)\n", hipGetErrorString(e), grid);
#else
    for (int li = 0; li < NPHASE; ++li) { a.ph_lo = li; a.ph_hi = li + 1; hipLaunchKernelGGL(mega, dim3(grid), dim3(NWAVES * 64), LDS_BYTES, stream, a); }
#endif
}
```

```cpp
#include <hip/hip_runtime.h>
#include <hip/hip_cooperative_groups.h>
#include <cstdio>
#include <cstdint>
namespace cg = cooperative_groups;

#ifndef N_LAUNCHES
#define N_LAUNCHES 1
#endif

namespace pg8 {
#define PG8_LAS __attribute__((address_space(3)))
typedef unsigned short bf16_t;
typedef short bf16x8 __attribute__((ext_vector_type(8)));
typedef float f32x4 __attribute__((ext_vector_type(4)));
typedef unsigned u32x4 __attribute__((ext_vector_type(4)));
constexpr int BM = 256, BK = 64, HALF = 128, HTB = HALF * BK * 2  , STAGE_BYTES = 8 * HTB, NXCD = 8, WGM = 8;

__host__ __device__ __forceinline__ int lds_byte(int r, int c) { const int st = (r >> 4) * 2 + (c >> 5), rr = r & 15, cc = c & 31, ob = rr * 64 + cc * 2; return st * 1024 + (ob ^ (((ob >> 9) & 1) << 5)); }
__host__ __device__ __forceinline__ void stage_rc(int b, int& R, int& C) { const int st = b / 1024, sb = b % 1024, swz = sb ^ (((sb >> 9) & 1) << 5); R = (st >> 1) * 16 + swz / 64; C = (st & 1) * 32 + (swz % 64) / 2; }
__host__ __device__ __forceinline__ int perm32(int rho) { const int n = rho >> 4, i = rho & 15; return 8 * (i >> 2) + 4 * n + (i & 3); }

struct Unit { int pm, pn; const char* a; const char* b; };
struct Gemm { int K, lda, ldb; };

struct StaticOrder {
    int nM, nN, nwg, G, c;
    __host__ __device__ void init(int M, int N, int G_, int c_) { nM = M / BM; nN = N / BM; nwg = nM * nN; G = G_; c = c_; }
    __host__ __device__ bool next(int i, Unit& u) const {
        const long L = (long)i * G + c; if (L >= nwg) return false;
        int wgid = (int)L; { const int q = nwg / NXCD, r = nwg % NXCD, xcd = wgid % NXCD, off = wgid / NXCD; wgid = (xcd < r ? xcd * (q + 1) : r * (q + 1) + (xcd - r) * q) + off; }
        const int nig = WGM * nN, gid = wgid / nig, fm = gid * WGM, gsz = (nM - fm) < WGM ? (nM - fm) : WGM;
        u.pm = fm + ((wgid % nig) % gsz); u.pn = (wgid % nig) / gsz; return true;
    }
};
__device__ __forceinline__ unsigned cvt_pk_bf16(float lo, float hi) { unsigned r; asm volatile("v_cvt_pk_bf16_f32 %0, %1, %2" : "=v"(r) : "v"(lo), "v"(hi)); return r; }

__device__ __forceinline__ u32x4 pack8(f32x4 v0, f32x4 v1) { u32x4 w; w.x = cvt_pk_bf16(v0[0], v0[1]); w.y = cvt_pk_bf16(v0[2], v0[3]); w.z = cvt_pk_bf16(v1[0], v1[1]); w.w = cvt_pk_bf16(v1[2], v1[3]); return w; }
__device__ __forceinline__ float sum16(const float* sp) { const f32x4 a = *(const f32x4*)sp, b = *(const f32x4*)(sp + 4), c = *(const f32x4*)(sp + 8), d = *(const f32x4*)(sp + 12);
    return ((a[0] + a[1]) + (a[2] + a[3])) + ((b[0] + b[1]) + (b[2] + b[3])) + ((c[0] + c[1]) + (c[2] + c[3])) + ((d[0] + d[1]) + (d[2] + d[3])); }

#define WT_RSRC(p) __builtin_amdgcn_make_buffer_rsrc((void*)(p), 0, 0x7ffffff0, 0x00020000)
__device__ __forceinline__ void st16wt(__amdgpu_buffer_rsrc_t r, size_t elem_off, u32x4 w) { __builtin_amdgcn_raw_buffer_store_b128(w, r, (unsigned)(elem_off * 2), 0,   16); }
__device__ __forceinline__ void row_scales(const float* SS, int row0, int fq, float (&rs)[2][4]) {
    f32x4 t[2][4];
#pragma unroll
    for (int ai = 0; ai < 2; ++ai)
#pragma unroll
        for (int m = 0; m < 4; ++m) t[ai][m] = *(const f32x4*)(SS + (size_t)(row0 + ai * HALF + m * 16) * 16 + fq * 4);
#pragma unroll
    for (int ai = 0; ai < 2; ++ai)
#pragma unroll
        for (int m = 0; m < 4; ++m) { float s = (t[ai][m][0] + t[ai][m][1]) + (t[ai][m][2] + t[ai][m][3]); s += __shfl_xor(s, 16); s += __shfl_xor(s, 32); rs[ai][m] = __builtin_amdgcn_rsqf(s * (1.0f / 1024.0f) + 1e-6f); }
}
struct EpiStore {
    static constexpr bool PERM = true, AFTER_DRAIN = false;
    bf16_t* O; int ldc; int npn_scaled; float scale0;
    __device__ __forceinline__ void operator()(f32x4 (&acc)[2][2][4][2], const Unit& u, int wr, int wc, int fr, int fq) const {
        const int row0 = u.pm * BM + wr * 64 + fr, col0 = u.pn * BM + wc * 32 + 8 * fq;
        const float sc = (u.pn < npn_scaled) ? scale0 : 1.0f;
        const __amdgpu_buffer_rsrc_t ors = WT_RSRC(O);
#pragma unroll
        for (int ai = 0; ai < 2; ++ai)
#pragma unroll
            for (int m = 0; m < 4; ++m) { const size_t ro = (size_t)(row0 + ai * HALF + m * 16) * ldc + col0;
#pragma unroll
                for (int bj = 0; bj < 2; ++bj) st16wt(ors, ro + bj * HALF, pack8(acc[ai][bj][m][0] * sc, acc[ai][bj][m][1] * sc)); }
    }
};
struct EpiProj {
    static constexpr bool PERM = true, AFTER_DRAIN = false;
    bf16_t* PC; bf16_t* QKV; float scale0;
    __device__ __forceinline__ void operator()(f32x4 (&acc)[2][2][4][2], const Unit& u, int wr, int wc, int fr, int fq) const {
        const int row0 = u.pm * BM + wr * 64 + fr;
        const __amdgpu_buffer_rsrc_t prs = WT_RSRC(PC), qrs = WT_RSRC(QKV);
        if (u.pn >= 6) {
            const int col0 = (u.pn - 6) * BM + wc * 32 + 8 * fq;
#pragma unroll
            for (int ai = 0; ai < 2; ++ai)
#pragma unroll
                for (int m = 0; m < 4; ++m) { const size_t ro = (size_t)(row0 + ai * HALF + m * 16) * 1536 + col0;
#pragma unroll
                    for (int bj = 0; bj < 2; ++bj) st16wt(prs, ro + bj * HALF, pack8(acc[ai][bj][m][0], acc[ai][bj][m][1])); }
        } else {
            const float sc = (u.pn < 2) ? scale0 : 1.0f;
            const int which = u.pn >> 1, d = (wc & 1) * 32 + 8 * fq;
            const size_t base = (size_t)which * 32768 * 512 + d;
#pragma unroll
            for (int ai = 0; ai < 2; ++ai)
#pragma unroll
                for (int m = 0; m < 4; ++m) { const int row = row0 + ai * HALF + m * 16;
#pragma unroll
                    for (int bj = 0; bj < 2; ++bj) { const int h = 4 * (u.pn & 1) + 2 * bj + (wc >> 1);
                        st16wt(qrs, base + ((size_t)((row >> 12) * 8 + h) * 4096 + (row & 4095)) * 64, pack8(acc[ai][bj][m][0] * sc, acc[ai][bj][m][1] * sc)); } }
        }
    }
};
template <bool BASE_BF16> struct EpiResid {
    static constexpr bool PERM = true, AFTER_DRAIN = false;
    const void* base; float* out; bf16_t* xb; float* SS;
    __device__ __forceinline__ void operator()(f32x4 (&acc)[2][2][4][2], const Unit& u, int wr, int wc, int fr, int fq) const {
        const int row0 = u.pm * BM + wr * 64 + fr, col0 = u.pn * BM + wc * 32 + 8 * fq;
        const __amdgpu_buffer_rsrc_t xrs = WT_RSRC(xb);
#pragma unroll
        for (int ai = 0; ai < 2; ++ai) {
            u32x4 wb[4][2]; f32x4 fb[4][2][2];
#pragma unroll
            for (int m = 0; m < 4; ++m)
#pragma unroll
                for (int bj = 0; bj < 2; ++bj) { const size_t off = (size_t)(row0 + ai * HALF + m * 16) * 1024 + col0 + bj * HALF;
                    if (BASE_BF16) wb[m][bj] = *(const u32x4*)((const bf16_t*)base + off);
                    else { fb[m][bj][0] = *(const f32x4*)((const float*)base + off); fb[m][bj][1] = *(const f32x4*)((const float*)base + off + 4); } }
#pragma unroll
            for (int m = 0; m < 4; ++m) { const int row = row0 + ai * HALF + m * 16; float ss = 0.f;
#pragma unroll
                for (int bj = 0; bj < 2; ++bj) { const size_t off = (size_t)row * 1024 + col0 + bj * HALF;
                    f32x4 b0, b1;
                    if (BASE_BF16) { const u32x4 w = wb[m][bj];
                        b0 = (f32x4){__uint_as_float(w.x << 16), __uint_as_float(w.x & 0xffff0000u), __uint_as_float(w.y << 16), __uint_as_float(w.y & 0xffff0000u)};
                        b1 = (f32x4){__uint_as_float(w.z << 16), __uint_as_float(w.z & 0xffff0000u), __uint_as_float(w.w << 16), __uint_as_float(w.w & 0xffff0000u)}; }
                    else { b0 = fb[m][bj][0]; b1 = fb[m][bj][1]; }
                    const f32x4 v0 = acc[ai][bj][m][0] + b0, v1 = acc[ai][bj][m][1] + b1;
                    if (out) { *(f32x4*)(out + off) = v0; *(f32x4*)(out + off + 4) = v1; }
                    if (xb) st16wt(xrs, off, pack8(v0, v1));
                    ss += ((v0[0] * v0[0] + v0[1] * v0[1]) + (v0[2] * v0[2] + v0[3] * v0[3])) + ((v1[0] * v1[0] + v1[1] * v1[1]) + (v1[2] * v1[2] + v1[3] * v1[3])); }
                if (SS) { ss += __shfl_xor(ss, 16); ss += __shfl_xor(ss, 32); if (fq == 0) SS[(size_t)row * 16 + u.pn * 4 + wc] = ss; } }
            asm volatile("" ::: "memory");
        }
    }
};
struct EpiRelu2 {
    static constexpr bool PERM = true, AFTER_DRAIN = false;
    const float* SS; bf16_t* O; int ldo;
    __device__ __forceinline__ void operator()(f32x4 (&acc)[2][2][4][2], const Unit& u, int wr, int wc, int fr, int fq) const {
        const int row0 = u.pm * BM + wr * 64 + fr, col0 = u.pn * BM + wc * 32 + 8 * fq;
        float rsv[2][4]; row_scales(SS, row0, fq, rsv);
#pragma unroll
        for (int ai = 0; ai < 2; ++ai)
#pragma unroll
            for (int m = 0; m < 4; ++m) { const int row = row0 + ai * HALF + m * 16;
                const float rs = rsv[ai][m];
                bf16_t* rowp = O + (size_t)row * ldo + col0;
#pragma unroll
                for (int bj = 0; bj < 2; ++bj) { f32x4 v0 = acc[ai][bj][m][0] * rs, v1 = acc[ai][bj][m][1] * rs;
#pragma unroll
                    for (int e = 0; e < 4; ++e) { const float a = fmaxf(v0[e], 0.f), b = fmaxf(v1[e], 0.f); v0[e] = a * a; v1[e] = b * b; }
                    __builtin_nontemporal_store(pack8(v0, v1), (u32x4*)(rowp + bj * HALF)); } }
    }
};
struct EpiSoftmax {
    static constexpr bool PERM = true, AFTER_DRAIN = false;
    const float* SS; bf16_t* P; PG8_LAS float* xch;
    __device__ __forceinline__ void operator()(f32x4 (&acc)[2][2][4][2], const Unit& u, int wr, int wc, int fr, int fq) const {
        const int row0 = u.pm * BM + wr * 64 + fr, col0 = u.pn * BM + wc * 32 + 8 * fq;
        const __amdgpu_buffer_rsrc_t prs = WT_RSRC(P);
        float mw[2][4];
        float rsv[2][4]; row_scales(SS, row0, fq, rsv);
#pragma unroll
        for (int ai = 0; ai < 2; ++ai)
#pragma unroll
            for (int m = 0; m < 4; ++m) { const int rl = ai * HALF + wr * 64 + m * 16 + fr;
                const float sc = rsv[ai][m] * (0.0625f * 1.4426950408889634f);
                float mx = -3.0e38f;
#pragma unroll
                for (int bj = 0; bj < 2; ++bj)
#pragma unroll
                    for (int n = 0; n < 2; ++n) { f32x4 v = acc[ai][bj][m][n] * sc; acc[ai][bj][m][n] = v; mx = fmaxf(mx, fmaxf(fmaxf(v[0], v[1]), fmaxf(v[2], v[3]))); }
                mx = fmaxf(mx, __shfl_xor(mx, 16)); mx = fmaxf(mx, __shfl_xor(mx, 32));
                float l = 0.f;
#pragma unroll
                for (int bj = 0; bj < 2; ++bj)
#pragma unroll
                    for (int n = 0; n < 2; ++n) { f32x4 v = acc[ai][bj][m][n];
#pragma unroll
                        for (int e = 0; e < 4; ++e) { v[e] = __builtin_amdgcn_exp2f(v[e] - mx); l += v[e]; }
                        acc[ai][bj][m][n] = v; }
                l += __shfl_xor(l, 16); l += __shfl_xor(l, 32);
                mw[ai][m] = mx;
                if (fq == 0) { xch[rl * 8 + wc * 2] = mx; xch[rl * 8 + wc * 2 + 1] = l; } }
        asm volatile("s_waitcnt lgkmcnt(0)\n\ts_barrier" ::: "memory");
#pragma unroll
        for (int ai = 0; ai < 2; ++ai)
#pragma unroll
            for (int m = 0; m < 4; ++m) { const int row = row0 + ai * HALF + m * 16; const int rl = ai * HALF + wr * 64 + m * 16 + fr;
                const f32x4 x0 = *(const PG8_LAS f32x4*)(xch + rl * 8), x1 = *(const PG8_LAS f32x4*)(xch + rl * 8 + 4);
                const float M = fmaxf(fmaxf(x0[0], x0[2]), fmaxf(x1[0], x1[2]));
                const float L = (x0[1] * __builtin_amdgcn_exp2f(x0[0] - M) + x0[3] * __builtin_amdgcn_exp2f(x0[2] - M)) + (x1[1] * __builtin_amdgcn_exp2f(x1[0] - M) + x1[3] * __builtin_amdgcn_exp2f(x1[2] - M));
                const float fac = __builtin_amdgcn_exp2f(mw[ai][m] - M) * __builtin_amdgcn_rcpf(L);
                bf16_t* rowp = P + (size_t)row * 1024 + col0;
#pragma unroll
                for (int bj = 0; bj < 2; ++bj) st16wt(prs, (size_t)row * 1024 + col0 + bj * HALF, pack8(acc[ai][bj][m][0] * fac, acc[ai][bj][m][1] * fac)); }
        asm volatile("s_waitcnt lgkmcnt(0)" ::: "memory");
    }
};

struct EpiFinal {
    static constexpr bool PERM = true, AFTER_DRAIN = false;
    const bf16_t* base; float* out; const float* gain; unsigned* slots; unsigned* cnt; PG8_LAS float* tab;
    __device__ __forceinline__ void operator()(f32x4 (&acc)[2][2][4][2], const Unit& u, int wr, int wc, int fr, int fq) const {
        const int row0 = u.pm * BM + wr * 64 + fr, col0 = u.pn * BM + wc * 32 + 8 * fq;
        const int lane = fr + 16 * fq, wid = wr * 4 + wc;
        PG8_LAS float* Ptab = tab; PG8_LAS float* Stab = tab + 1024;
#pragma unroll
        for (int ai = 0; ai < 2; ++ai)
#pragma unroll
            for (int m = 0; m < 4; ++m) { const int row = row0 + ai * HALF + m * 16; float ss = 0.f;
#pragma unroll
                for (int bj = 0; bj < 2; ++bj) { const size_t off = (size_t)row * 1024 + col0 + bj * HALF;
                    const u32x4 w = *(const u32x4*)(base + off);
                    const f32x4 b0 = (f32x4){__uint_as_float(w.x << 16), __uint_as_float(w.x & 0xffff0000u), __uint_as_float(w.y << 16), __uint_as_float(w.y & 0xffff0000u)};
                    const f32x4 b1 = (f32x4){__uint_as_float(w.z << 16), __uint_as_float(w.z & 0xffff0000u), __uint_as_float(w.w << 16), __uint_as_float(w.w & 0xffff0000u)};
                    const f32x4 v0 = acc[ai][bj][m][0] + b0, v1 = acc[ai][bj][m][1] + b1; acc[ai][bj][m][0] = v0; acc[ai][bj][m][1] = v1;
                    ss += ((v0[0] * v0[0] + v0[1] * v0[1]) + (v0[2] * v0[2] + v0[3] * v0[3])) + ((v1[0] * v1[0] + v1[1] * v1[1]) + (v1[2] * v1[2] + v1[3] * v1[3])); }
                ss += __shfl_xor(ss, 16); ss += __shfl_xor(ss, 32);
                if (fq == 0) Ptab[(ai * HALF + wr * 64 + m * 16 + fr) * 4 + wc] = ss; }
        asm volatile("s_waitcnt lgkmcnt(0)\n\ts_barrier" ::: "memory");
        const int rowl = wid * 32 + (lane & 31);
        if (lane < 32) { const f32x4 p = *(const PG8_LAS f32x4*)(Ptab + rowl * 4);
            __hip_atomic_store(slots + ((size_t)(u.pm * BM + rowl) * 4 + u.pn), __float_as_uint((p[0] + p[1]) + (p[2] + p[3])), __ATOMIC_RELAXED, __HIP_MEMORY_SCOPE_AGENT); }
        asm volatile("s_waitcnt vmcnt(0)" ::: "memory");
        if (lane == 0) __hip_atomic_fetch_add(cnt + 64 * u.pm, 1u, __ATOMIC_RELAXED, __HIP_MEMORY_SCOPE_AGENT);
        if (wid == 0) {
            unsigned sp = 0;
            while ((unsigned)__builtin_amdgcn_readfirstlane(__hip_atomic_load(cnt + 64 * u.pm, __ATOMIC_RELAXED, __HIP_MEMORY_SCOPE_AGENT)) < 32u) { __builtin_amdgcn_s_sleep(2); if (++sp > (1u << 22)) break; }
            __builtin_amdgcn_fence(__ATOMIC_ACQUIRE, "agent");
        }
        asm volatile("s_waitcnt vmcnt(0) lgkmcnt(0)\n\ts_barrier" ::: "memory");
        if (lane < 32) { const unsigned* sl = slots + (size_t)(u.pm * BM + rowl) * 4; float t = 0.f;
#pragma unroll
            for (int k = 0; k < 4; ++k) t += __uint_as_float(__hip_atomic_load(sl + k, __ATOMIC_RELAXED, __HIP_MEMORY_SCOPE_AGENT));
            Stab[rowl] = 1.0f / sqrtf(t * (1.0f / 1024.0f) + 1e-6f); }
        asm volatile("s_waitcnt vmcnt(0) lgkmcnt(0)\n\ts_barrier" ::: "memory");
        f32x4 g[2][2];
#pragma unroll
        for (int bj = 0; bj < 2; ++bj) { g[bj][0] = *(const f32x4*)(gain + col0 + bj * HALF); g[bj][1] = *(const f32x4*)(gain + col0 + bj * HALF + 4); }
#pragma unroll
        for (int ai = 0; ai < 2; ++ai)
#pragma unroll
            for (int m = 0; m < 4; ++m) { const int row = row0 + ai * HALF + m * 16; const float rs = Stab[ai * HALF + wr * 64 + m * 16 + fr];
#pragma unroll
                for (int bj = 0; bj < 2; ++bj) { const size_t off = (size_t)row * 1024 + col0 + bj * HALF;
                    *(f32x4*)(out + off) = acc[ai][bj][m][0] * rs * g[bj][0]; *(f32x4*)(out + off + 4) = acc[ai][bj][m][1] * rs * g[bj][1]; } }
        asm volatile("s_waitcnt lgkmcnt(0)" ::: "memory");
    }
};

template <class Epi, class Sched, bool ALIGN_EPI = false, bool SP2 = false>
__device__ __forceinline__ void gemm_phase(PG8_LAS unsigned char* lds, const Gemm g, const Sched& S, const Epi& E) {
    int tid = threadIdx.x; asm volatile("" : "+v"(tid));
    const int wid = __builtin_amdgcn_readfirstlane(tid >> 6), lane = tid & 63, wr = wid >> 2, wc = wid & 3, fr = lane & 15, fq = lane >> 4;
    const int K = g.K, nt = K / BK;
    unsigned voffA[2], voffB[2];
#pragma unroll
    for (int i = 0; i < 2; ++i) { int R, C; stage_rc(tid * 16 + i * 8192, R, C); const int Rb = Epi::PERM ? ((R & ~31) + perm32(R & 31)) : R;
        voffA[i] = (unsigned)(R * g.lda + C) * 2u; voffB[i] = (unsigned)(Rb * g.ldb + C) * 2u; }
    const size_t kstep = (size_t)(BK * 2);
    const size_t hstepA = (size_t)HALF * g.lda * 2, hstepB = (size_t)HALF * g.ldb * 2;
        const unsigned ldsw = (unsigned)wid * 1024u;
    const int aoff = lds_byte(wr * 64 + fr, fq * 8), boff = lds_byte(wc * 32 + fr, fq * 8);
#define PG8_SA(b, h) (((b) * 2 + (h)) * HTB)
#define PG8_SB(b, h) ((4 + (b) * 2 + (h)) * HTB)
#define PG8_STAGE(bufoff, gbase, voff) do { _Pragma("unroll") for (int _i = 0; _i < 2; ++_i) \
        __builtin_amdgcn_global_load_lds((const unsigned*)((const char*)(gbase) + (voff)[_i]), (PG8_LAS unsigned*)(lds + (bufoff) + ldsw + _i * 8192), 16, 0, 0); } while (0)
#define PG8_LDA(dst, b, h) do { _Pragma("unroll") for (int m = 0; m < 4; ++m) _Pragma("unroll") for (int k = 0; k < 2; ++k) dst[m][k] = *(const PG8_LAS bf16x8*)(lds + PG8_SA(b, h) + aoff + m * 2048 + k * 1024); } while (0)
#define PG8_LDB(dst, b, h) do { _Pragma("unroll") for (int n = 0; n < 2; ++n) _Pragma("unroll") for (int k = 0; k < 2; ++k) dst[n][k] = *(const PG8_LAS bf16x8*)(lds + PG8_SB(b, h) + boff + n * 2048 + k * 1024); } while (0)
#define PG8_MMA(ai, bj, At, Bt) do { __builtin_amdgcn_s_setprio(1); _Pragma("unroll") for (int m = 0; m < 4; ++m) _Pragma("unroll") for (int n = 0; n < 2; ++n) _Pragma("unroll") for (int k = 0; k < 2; ++k) \
        acc[ai][bj][m][n] = __builtin_amdgcn_mfma_f32_16x16x32_bf16(Bt[n][k], At[m][k], acc[ai][bj][m][n], 0, 0, 0); __builtin_amdgcn_s_setprio(0); } while (0)
#define PG8_WAIT_V(n) asm volatile("s_waitcnt vmcnt(" #n ")" ::: "memory")
#define PG8_WAIT_L(n) asm volatile("s_waitcnt lgkmcnt(" #n ")" ::: "memory")
#define PG8_BAR __builtin_amdgcn_s_barrier()
#define PG8_SCHED __builtin_amdgcn_sched_barrier(0)
    Unit cur, nxt; int ui = 0;
    if (!S.next(0, cur)) return;
    f32x4 acc[2][2][4][2];
#pragma unroll
    for (int a = 0; a < 2; ++a)
#pragma unroll
        for (int b = 0; b < 2; ++b)
#pragma unroll
            for (int m = 0; m < 4; ++m)
#pragma unroll
                for (int n = 0; n < 2; ++n) acc[a][b][m][n] = (f32x4){0.f, 0.f, 0.f, 0.f};
    bf16x8 At[4][2], B0[2][2], B1[2][2];
    const char* cA = cur.a; const char* cB = cur.b;
    S.a_ready(cur);
    if constexpr (SP2) {
        PG8_STAGE(PG8_SB(0, 0), cB, voffB); PG8_STAGE(PG8_SB(0, 1), cB + hstepB, voffB); PG8_STAGE(PG8_SA(0, 0), cA, voffA); PG8_STAGE(PG8_SA(0, 1), cA + hstepA, voffA);
        if (wr == 1) PG8_BAR;
        PG8_WAIT_V(2); PG8_BAR;
        PG8_STAGE(PG8_SB(1, 0), cB + kstep, voffB); PG8_STAGE(PG8_SA(1, 0), cA + kstep, voffA); PG8_STAGE(PG8_SB(1, 1), cB + hstepB + kstep, voffB);
        PG8_WAIT_V(6); PG8_BAR;
    } else {
        PG8_STAGE(PG8_SB(0, 0), cB, voffB); PG8_STAGE(PG8_SA(0, 0), cA, voffA); PG8_STAGE(PG8_SB(0, 1), cB + hstepB, voffB); PG8_STAGE(PG8_SA(0, 1), cA + hstepA, voffA);
        if (wr == 1) PG8_BAR;
        PG8_WAIT_V(4); PG8_BAR;
        PG8_STAGE(PG8_SB(1, 0), cB + kstep, voffB); PG8_STAGE(PG8_SA(1, 0), cA + kstep, voffA); PG8_STAGE(PG8_SB(1, 1), cB + hstepB + kstep, voffB);
        PG8_WAIT_V(6); PG8_BAR;
    }
    for (;;) {
        const bool has_next = S.next(ui + 1, nxt);
        const char* nA = has_next ? nxt.a : cA; const char* nB = has_next ? nxt.b : cB;
        for (int t = 0; t < nt; t += 2) {
            const bool last = (t == nt - 2);
            const char* a1 = cA + (size_t)(t + 1) * kstep;
            const char* a2 = last ? nA : cA + (size_t)(t + 2) * kstep; const char* b2 = last ? nB : cB + (size_t)(t + 2) * kstep;
            const char* a3 = a2 + kstep; const char* b3 = b2 + kstep;
            if (last && has_next) S.a_ready(nxt);
            if constexpr (SP2) {
            PG8_LDB(B0, 0, 0); PG8_LDB(B1, 0, 1); PG8_SCHED; PG8_LDA(At, 0, 0); PG8_STAGE(PG8_SA(1, 1), a1 + hstepA, voffA);
            PG8_WAIT_V(8); PG8_WAIT_L(0); PG8_BAR; PG8_MMA(0, 0, At, B0); PG8_MMA(0, 1, At, B1); PG8_BAR; PG8_SCHED;
            PG8_LDA(At, 0, 1); PG8_STAGE(PG8_SB(0, 0), b2, voffB); PG8_STAGE(PG8_SB(0, 1), b2 + hstepB, voffB); PG8_STAGE(PG8_SA(0, 0), a2, voffA);
            PG8_WAIT_V(8); PG8_WAIT_L(0); PG8_BAR; PG8_MMA(1, 0, At, B0); PG8_MMA(1, 1, At, B1); PG8_BAR; PG8_SCHED;
            PG8_LDB(B0, 1, 0); PG8_LDB(B1, 1, 1); PG8_SCHED; PG8_LDA(At, 1, 0); PG8_STAGE(PG8_SA(0, 1), a2 + hstepA, voffA);
            PG8_WAIT_V(8); PG8_WAIT_L(0); PG8_BAR; PG8_MMA(0, 0, At, B0); PG8_MMA(0, 1, At, B1); PG8_BAR; PG8_SCHED;
            PG8_LDA(At, 1, 1); PG8_STAGE(PG8_SB(1, 0), b3, voffB); PG8_STAGE(PG8_SB(1, 1), b3 + hstepB, voffB); PG8_STAGE(PG8_SA(1, 0), a3, voffA);
            PG8_WAIT_V(8); PG8_WAIT_L(0); PG8_BAR; PG8_MMA(1, 0, At, B0); PG8_MMA(1, 1, At, B1); PG8_BAR; PG8_SCHED;
            } else {
            PG8_LDB(B0, 0, 0); PG8_SCHED; PG8_LDA(At, 0, 0); PG8_STAGE(PG8_SA(1, 1), a1 + hstepA, voffA);
            PG8_WAIT_L(8); PG8_BAR; PG8_WAIT_L(0); PG8_MMA(0, 0, At, B0); PG8_BAR; PG8_SCHED;
            PG8_LDB(B1, 0, 1); PG8_STAGE(PG8_SB(0, 0), b2, voffB);
            PG8_BAR; PG8_WAIT_L(0); PG8_MMA(0, 1, At, B1); PG8_BAR;
            PG8_LDA(At, 0, 1); PG8_STAGE(PG8_SA(0, 0), a2, voffA);
            PG8_BAR; PG8_WAIT_L(0); PG8_MMA(1, 0, At, B0); PG8_BAR; PG8_SCHED;
            PG8_STAGE(PG8_SB(0, 1), b2 + hstepB, voffB);
            PG8_WAIT_V(6); PG8_BAR; PG8_MMA(1, 1, At, B1); PG8_BAR;
            PG8_LDB(B0, 1, 0); PG8_SCHED; PG8_LDA(At, 1, 0); PG8_STAGE(PG8_SA(0, 1), a2 + hstepA, voffA);
            PG8_WAIT_L(8); PG8_BAR; PG8_WAIT_L(0); PG8_MMA(0, 0, At, B0); PG8_BAR; PG8_SCHED;
            PG8_LDB(B1, 1, 1); PG8_STAGE(PG8_SB(1, 0), b3, voffB);
            PG8_BAR; PG8_WAIT_L(0); PG8_MMA(0, 1, At, B1); PG8_BAR;
            PG8_LDA(At, 1, 1); PG8_STAGE(PG8_SA(1, 0), a3, voffA);
            PG8_BAR; PG8_WAIT_L(0); PG8_MMA(1, 0, At, B0); PG8_BAR; PG8_SCHED;
            PG8_STAGE(PG8_SB(1, 1), b3 + hstepB, voffB);
            PG8_WAIT_V(6); PG8_BAR; PG8_MMA(1, 1, At, B1); PG8_BAR;
            }
        }
        if constexpr (ALIGN_EPI) { if (wr == 0) PG8_BAR; }
        if constexpr (!Epi::AFTER_DRAIN) { E(acc, cur, wr, wc, fr, fq); S.done(cur); }
        if (!has_next) break;
#pragma unroll
        for (int a = 0; a < 2; ++a)
#pragma unroll
            for (int b = 0; b < 2; ++b)
#pragma unroll
                for (int m = 0; m < 4; ++m)
#pragma unroll
                    for (int n = 0; n < 2; ++n) acc[a][b][m][n] = (f32x4){0.f, 0.f, 0.f, 0.f};
        cur = nxt; cA = nA; cB = nB; ++ui;
        if constexpr (ALIGN_EPI) { if (wr == 1) PG8_BAR; }
    }
    PG8_WAIT_V(0);
    if constexpr (!ALIGN_EPI) { if (wr == 0) PG8_BAR; }
    PG8_BAR;
    if constexpr (Epi::AFTER_DRAIN) { E.fused(acc, cur, wr, wc, fr, fq, lds, wid, lane); S.done(cur); }
#undef PG8_SA
#undef PG8_SB
#undef PG8_STAGE
#undef PG8_LDA
#undef PG8_LDB
#undef PG8_MMA
#undef PG8_WAIT_V
#undef PG8_WAIT_L
#undef PG8_BAR
#undef PG8_SCHED
}}

struct SchedStd {
    pg8::StaticOrder so; const char* A; const char* B; size_t tA, tB, bstride; int bshift;
    __device__ __forceinline__ void init(const void* A_, int lda, const void* B_, int ldb, int M, int N, int G, int c, int bshift_ = 30, size_t bstride_ = 0) {
        so.init(M, N, G, c); A = (const char*)A_; B = (const char*)B_; tA = (size_t)256 * lda * 2; tB = (size_t)256 * ldb * 2; bshift = bshift_; bstride = bstride_; }
    __device__ __forceinline__ bool next(int i, pg8::Unit& u) const { if (!so.next(i, u)) return false; u.a = A + (size_t)u.pm * tA; u.b = B + (size_t)u.pn * tB + (size_t)(u.pm >> bshift) * bstride; return true; }
    __device__ __forceinline__ void a_ready(const pg8::Unit&) const {}
    __device__ __forceinline__ void done(const pg8::Unit&) const {}
};
struct SchedMt {
    int G, c; const char* KV; const char* WqS;
    __device__ __forceinline__ bool next(int i, pg8::Unit& u) const { const int L = i * G + c; if (L >= 128) return false; const int b = L >> 4, h = (L >> 2) & 3, pn = L & 3;
        u.pm = b * 4 + h; u.pn = pn; u.a = KV + ((size_t)(b * 256) * 2048 + h * 256) * 2; u.b = WqS + ((size_t)pn * 256 * 1024 + h * 256) * 2; return true; }
    __device__ __forceinline__ void a_ready(const pg8::Unit&) const {}
    __device__ __forceinline__ void done(const pg8::Unit&) const {}
};
struct SchedNt {
    int G, c; const char* KV; const char* WoT;
    __device__ __forceinline__ bool next(int i, pg8::Unit& u) const { const int L = i * G + ((c + G / 2) % G); if (L >= 128) return false; const int b = L >> 4, pmc = (L >> 2) & 3, h = L & 3;
        u.pm = b * 4 + pmc; u.pn = h; u.a = WoT + ((size_t)pmc * 256 * 1024 + h * 256) * 2; u.b = KV + ((size_t)(b * 256) * 2048 + 1024 + h * 256) * 2; return true; }
    __device__ __forceinline__ void a_ready(const pg8::Unit&) const {}
    __device__ __forceinline__ void done(const pg8::Unit&) const {}
};

constexpr int NB = 8, SEQ = 4096, DM = 1024, MTOK = NB * SEQ, MEMLEN = 256, MMEM = NB * MEMLEN, INC = 3072, FF = 4096, AW = 512;
constexpr float EPS = 1e-6f, LOG2E = 1.4426950408889634f;
constexpr int NWAVES = 8;
constexpr size_t MiB = 1u << 20;
constexpr size_t WS_WIN = 1 * MiB, WS_WOUT = 7 * MiB, WS_WQS = 9 * MiB, WS_WKV = 11 * MiB, WS_WO = 15 * MiB, WS_WUP = 17 * MiB, WS_WDN = 25 * MiB;
constexpr size_t WS_MEMN = 33 * MiB, WS_KV = 37 * MiB, WS_MT = 45 * MiB, WS_NT = 61 * MiB, WS_SS1 = 77 * MiB, WS_SS2 = 79 * MiB;
constexpr size_t WS_H1 = 96 * MiB;
constexpr size_t WS_PROJ = 160 * MiB;
constexpr size_t WS_QKV = 256 * MiB;
constexpr int CONVP = 1536;
constexpr int HIDP = 4096 + 64;
constexpr size_t WS_MRG = 358 * MiB;
constexpr size_t WS_HID = 96 * MiB;
constexpr size_t WS_LSE = 82 * MiB;
constexpr size_t WS_OP01 = 96 * MiB;
constexpr size_t WS_OP2 = 422 * MiB;
constexpr size_t WS_END = 454 * MiB;
static_assert(WS_HID + (size_t)MTOK * HIDP * 2 <= WS_MRG && WS_MRG + (size_t)MTOK * 1024 * 2 <= WS_OP2 && WS_OP2 + (size_t)MTOK * AW * 2 <= WS_END, "d_ws map");
constexpr int RING_BYTES = 131072, XCH_OFF = RING_BYTES, LDS_BYTES = RING_BYTES + 8192 + 4096;

#define LAS __attribute__((address_space(3)))
typedef unsigned short bf16;
typedef float f32x4 __attribute__((ext_vector_type(4)));
typedef unsigned u32x4 __attribute__((ext_vector_type(4)));
typedef unsigned u32x2 __attribute__((ext_vector_type(2)));
#define LDS_WAIT() asm volatile("s_waitcnt lgkmcnt(0)" ::: "memory")
__device__ __forceinline__ unsigned f2bf(float f) { unsigned u = __builtin_bit_cast(unsigned, f); return (u + 0x7fffu + ((u >> 16) & 1u)) >> 16; }
__device__ __forceinline__ unsigned pk2(float lo, float hi) { return f2bf(lo) | (f2bf(hi) << 16); }
__device__ __forceinline__ float bf2f(unsigned v) { return __uint_as_float(v << 16); }
__device__ __forceinline__ float wave_sum(float v) {
#pragma unroll
    for (int o = 1; o < 64; o <<= 1) v += __shfl_xor(v, o);
    return v;
}

__device__ __forceinline__ void p0_transpose_item(const float* W, int K, int N, bf16* WT, const float* gain, LAS float* scr, int item, int lane) {
    const int nblk = N / 32, kb = item / nblk, nb = item % nblk, k0 = 64 * kb, n0 = 32 * nb;
    f32x4 v[8];
#pragma unroll
    for (int i = 0; i < 8; ++i) v[i] = __builtin_nontemporal_load((const f32x4*)(W + (size_t)(k0 + 8 * i + (lane >> 3)) * N + n0 + 4 * (lane & 7)));
#pragma unroll
    for (int i = 0; i < 8; ++i) { const int kk = 8 * i + (lane >> 3); const float g = gain ? gain[k0 + kk] : 1.0f; LAS float* d = scr + kk * 33 + 4 * (lane & 7);
        d[0] = v[i][0] * g; d[1] = v[i][1] * g; d[2] = v[i][2] * g; d[3] = v[i][3] * g; }
    LDS_WAIT(); asm volatile("" ::: "memory");
    const int c = lane & 7;
#pragma unroll
    for (int j = 0; j < 4; ++j) { const int n = (lane >> 3) + 8 * j; const LAS float* s = scr + (8 * c) * 33 + n;
        u32x4 o; o.x = pk2(s[0 * 33], s[1 * 33]); o.y = pk2(s[2 * 33], s[3 * 33]); o.z = pk2(s[4 * 33], s[5 * 33]); o.w = pk2(s[6 * 33], s[7 * 33]);
        *(u32x4*)(WT + (size_t)(n0 + n) * K + k0 + 8 * c) = o; }
    LDS_WAIT(); asm volatile("" ::: "memory");
}
__device__ __forceinline__ void rms_row_to_bf16(const float* xrow, const float* g, bf16* orow, int lane) {
    const f32x4* xr = (const f32x4*)xrow + lane; const f32x4* gr = (const f32x4*)g + lane;
    f32x4 v[4]; float s = 0.f;
#pragma unroll
    for (int j = 0; j < 4; ++j) { v[j] = xr[64 * j]; s += (v[j][0] * v[j][0] + v[j][1] * v[j][1]) + (v[j][2] * v[j][2] + v[j][3] * v[j][3]); }
    const float rs = 1.0f / sqrtf(wave_sum(s) * (1.0f / 1024.0f) + EPS);
    u32x2* o8 = (u32x2*)orow + lane;
#pragma unroll
    for (int j = 0; j < 4; ++j) { const f32x4 gv = gr[64 * j]; u32x2 o; o.x = pk2(v[j][0] * rs * gv[0], v[j][1] * rs * gv[1]); o.y = pk2(v[j][2] * rs * gv[2], v[j][3] * rs * gv[3]); o8[64 * j] = o; }
}

struct Args { const float* in[17]; float* out; unsigned char* ws; int ph_lo, ph_hi; };
enum { I_X = 0, I_MEM, I_GMIX, I_WIN, I_CONVW, I_GATT, I_GCONV, I_WOUT, I_GX, I_GMEM, I_WQ, I_WKV, I_WO, I_GMLP, I_WUP, I_WDN, I_GFIN };

__device__ __forceinline__ void p0_rows(const Args& a, int gw, int NGW, int lane) {
    const float* X = a.in[I_X]; const float* g = a.in[I_GMIX]; bf16* H1 = (bf16*)(a.ws + WS_H1);
    const f32x4* gr = (const f32x4*)g + lane;
#pragma unroll 1
    for (int m = gw; m < MTOK; m += 2 * NGW) {
        const int m2 = m + NGW; const bool has2 = m2 < MTOK;
        const f32x4* x0 = (const f32x4*)(X + (size_t)m * 1024) + lane; const f32x4* x1 = (const f32x4*)(X + (size_t)(has2 ? m2 : m) * 1024) + lane;
        f32x4 v[4], w[4]; float s0 = 0.f, s1 = 0.f;
#pragma unroll
        for (int j = 0; j < 4; ++j) { v[j] = __builtin_nontemporal_load(x0 + 64 * j); w[j] = __builtin_nontemporal_load(x1 + 64 * j); }
#pragma unroll
        for (int j = 0; j < 4; ++j) { s0 += (v[j][0] * v[j][0] + v[j][1] * v[j][1]) + (v[j][2] * v[j][2] + v[j][3] * v[j][3]); s1 += (w[j][0] * w[j][0] + w[j][1] * w[j][1]) + (w[j][2] * w[j][2] + w[j][3] * w[j][3]); }
#pragma unroll
        for (int o = 1; o < 64; o <<= 1) { s0 += __shfl_xor(s0, o); s1 += __shfl_xor(s1, o); }
        const float r0 = 1.0f / sqrtf(s0 * (1.0f / 1024.0f) + EPS), r1 = 1.0f / sqrtf(s1 * (1.0f / 1024.0f) + EPS);
        u32x2* o0 = (u32x2*)(H1 + (size_t)m * 1024) + lane; u32x2* o1 = (u32x2*)(H1 + (size_t)m2 * 1024) + lane;
#pragma unroll
        for (int j = 0; j < 4; ++j) { const f32x4 gv = gr[64 * j]; u32x2 o; o.x = pk2(v[j][0] * r0 * gv[0], v[j][1] * r0 * gv[1]); o.y = pk2(v[j][2] * r0 * gv[2], v[j][3] * r0 * gv[3]); o0[64 * j] = o;
            if (has2) { u32x2 p; p.x = pk2(w[j][0] * r1 * gv[0], w[j][1] * r1 * gv[1]); p.y = pk2(w[j][2] * r1 * gv[2], w[j][3] * r1 * gv[3]); o1[64 * j] = p; } }
    }
}
__device__ __forceinline__ void p0_prologue(const Args& a, LAS unsigned char* lds, int gw, int NGW, int wave, int lane) {
    unsigned char* ws = a.ws;
    LAS float* scr = (LAS float*)(lds + wave * 16384);
    constexpr int I_IN = 16 * 96, I_OUT = 16 * 32, I_KV = 16 * 64, I_O = 16 * 32, I_UP = 16 * 128, I_DN = 64 * 32;
    constexpr int NITEMS = I_IN + I_OUT + I_KV + I_O + I_UP + I_DN;
    const bool rows_first = (wave & 1) != 0;
    if (rows_first) p0_rows(a, gw, NGW, lane);
    for (int it = gw; it < NITEMS; it += NGW) {
        int r = it;
        if (r < I_IN) { p0_transpose_item(a.in[I_WIN], 1024, 3072, (bf16*)(ws + WS_WIN), nullptr, scr, r, lane); continue; } r -= I_IN;
        if (r < I_OUT) { p0_transpose_item(a.in[I_WOUT], 1024, 1024, (bf16*)(ws + WS_WOUT), nullptr, scr, r, lane); continue; } r -= I_OUT;
        if (r < I_KV) { p0_transpose_item(a.in[I_WKV], 1024, 2048, (bf16*)(ws + WS_WKV), nullptr, scr, r, lane); continue; } r -= I_KV;
        if (r < I_O) { p0_transpose_item(a.in[I_WO], 1024, 1024, (bf16*)(ws + WS_WO), nullptr, scr, r, lane); continue; } r -= I_O;
        if (r < I_UP) { p0_transpose_item(a.in[I_WUP], 1024, 4096, (bf16*)(ws + WS_WUP), a.in[I_GMLP], scr, r, lane); continue; } r -= I_UP;
        p0_transpose_item(a.in[I_WDN], 4096, 1024, (bf16*)(ws + WS_WDN), nullptr, scr, r, lane);
    }
    for (int c = gw; c < 1024; c += NGW) { const float g = a.in[I_GX][c]; const f32x4* wr_ = (const f32x4*)(a.in[I_WQ] + (size_t)c * 1024) + lane; u32x2* o8 = (u32x2*)((bf16*)(ws + WS_WQS) + (size_t)c * 1024) + lane;
#pragma unroll
        for (int j = 0; j < 4; ++j) { const f32x4 v = wr_[64 * j]; u32x2 o; o.x = pk2(v[0] * g, v[1] * g); o.y = pk2(v[2] * g, v[3] * g); o8[64 * j] = o; } }
    for (int m = gw; m < MMEM; m += NGW) rms_row_to_bf16(a.in[I_MEM] + (size_t)m * 1024, a.in[I_GMEM], (bf16*)(ws + WS_MEMN) + (size_t)m * 1024, lane);
    if (!rows_first) p0_rows(a, gw, NGW, lane);
}

__device__ __forceinline__ void unpack8(const u32x4 w, float (&f)[8]) {
#pragma unroll
    for (int i = 0; i < 4; ++i) { f[2 * i] = __uint_as_float(w[i] << 16); f[2 * i + 1] = __uint_as_float(w[i] & 0xffff0000u); }
}
typedef float f32x16 __attribute__((ext_vector_type(16)));
typedef short bf16x8 __attribute__((ext_vector_type(8)));
typedef short s16x4 __attribute__((ext_vector_type(4)));
__device__ __forceinline__ float swap32_max(float v) { auto rr = __builtin_amdgcn_permlane32_swap(__float_as_uint(v), __float_as_uint(v), false, false); return fmaxf(__uint_as_float(rr[0]), __uint_as_float(rr[1])); }
__device__ __forceinline__ float swap32_sum(float v) { auto rr = __builtin_amdgcn_permlane32_swap(__float_as_uint(v), __float_as_uint(v), false, false); return __uint_as_float(rr[0]) + __uint_as_float(rr[1]); }
__device__ __forceinline__ s16x4 vtr(const LAS unsigned char* p) { return __builtin_bit_cast(s16x4, __builtin_amdgcn_ds_read_tr16_b64_v4i16((LAS s16x4*)p)); }
__device__ __forceinline__ bf16x8 packp(const f32x16& p, int b) { u32x4 w; w.x = pg8::cvt_pk_bf16(p[b], p[b + 1]); w.y = pg8::cvt_pk_bf16(p[b + 2], p[b + 3]); w.z = pg8::cvt_pk_bf16(p[b + 4], p[b + 5]); w.w = pg8::cvt_pk_bf16(p[b + 6], p[b + 7]); return __builtin_bit_cast(bf16x8, w); }

constexpr int P2_UNITS = 3072, P2_KIMG = 0, P2_VIMG = 49152, P2_STAGE = 98304;
struct P2Unit { const bf16* pb; int h, p, dil, r, m0; size_t tokbase; };
__device__ __forceinline__ P2Unit p2_decode(int L, const bf16* proj) {
    P2Unit u; const int xcd = L & 7, idx = L >> 3, b = idx / 48, rem = idx % 48, uu = rem & 15; u.p = rem >> 4; u.h = xcd;
    const int dsh = 2 * u.p; u.dil = 1 << dsh; const int chunk = uu & ((16 >> dsh) - 1); u.r = uu >> (4 - dsh); u.m0 = chunk * 256;
    u.pb = proj + (size_t)(b * 8 + u.h) * SEQ * 64; u.tokbase = (size_t)b * SEQ; return u;
}
constexpr size_t QKV_PLANE = (size_t)MTOK * AW;
__device__ __forceinline__ void p2a_attn(const bf16* proj, bf16* op01, bf16* op2, float* lse, LAS unsigned char* lds, int G, int bx, int wave, int tid) {
    const int lane = tid & 63, r32 = lane & 31, hi = lane >> 5;
    const int vr_off = (4 * hi + ((lane & 15) >> 2)) * 64 + ((lane >> 4) & 1) * 32 + (lane & 3) * 8;
    u32x4 kreg[6], vreg[6], qn[4];
    LAS unsigned char* stage = lds + P2_STAGE + wave * 4096;
#define P2A_ISSUE(LL) do { const P2Unit un = p2_decode((LL), proj); \
        _Pragma("unroll") for (int j = 0; j < 4; ++j) { const int row = (lane >> 3) + 8 * j; \
          qn[j] = *(const u32x4*)(un.pb + (size_t)((un.m0 + 32 * wave + row) * un.dil + un.r) * 64 + (lane & 7) * 8); } \
        _Pragma("unroll") for (int j = 0; j < 6; ++j) { const int q = tid + 512 * j, row = q >> 3, ch = q & 7; const int pos = max(un.m0 - 128 + row, 0); \
          const bf16* kp = un.pb + QKV_PLANE + (size_t)(pos * un.dil + un.r) * 64 + ch * 8; kreg[j] = *(const u32x4*)kp; vreg[j] = *(const u32x4*)(kp + QKV_PLANE); } } while (0)
    const int xcd_ = bx & 7, cl = bx >> 3;
    const bool g256 = (G == 256);
    const int ncl = g256 ? 32 : (G + 7 - xcd_) / 8;
    const int cnt = g256 ? (cl < 8 ? 9 : 13) : (384 - cl + ncl - 1) / ncl;
#define P2A_IDX(k) ((g256 && (k) >= 9) ? 288 + 24 * ((k) - 9) + (cl - 8) : ncl * (k) + cl)
    if (cnt > 0) P2A_ISSUE(P2A_IDX(0) * 8 + xcd_);
#pragma unroll 1
    for (int k = 0; k < cnt; ++k) {
        const int L = P2A_IDX(k) * 8 + xcd_;
        const P2Unit u = p2_decode(L, proj);
        __syncthreads();
#pragma unroll
        for (int j = 0; j < 6; ++j) { const int q = tid + 512 * j, row = q >> 3, ch = q & 7;
            *(LAS u32x4*)(lds + P2_KIMG + row * 128 + ((ch ^ (row & 7)) * 16)) = kreg[j];
            *(LAS u32x4*)(lds + P2_VIMG + (row >> 5) * 4096 + (ch >> 2) * 2048 + (row & 31) * 64 + (ch & 3) * 16) = vreg[j]; }
#pragma unroll
        for (int j = 0; j < 4; ++j) { const int row = (lane >> 3) + 8 * j; *(LAS u32x4*)(stage + row * 128 + (((lane & 7) ^ (row & 7)) * 16)) = qn[j]; }
        asm volatile("" ::: "memory");
        bf16x8 qf[4];
#pragma unroll
        for (int d0 = 0; d0 < 4; ++d0) qf[d0] = *(const LAS bf16x8*)(stage + r32 * 128 + (((2 * d0 + hi) ^ (r32 & 7)) * 16));
        __syncthreads();
        if (k + 1 < cnt) P2A_ISSUE(P2A_IDX(k + 1) * 8 + xcd_);
        f32x16 pt[5];
#pragma unroll
        for (int j = 0; j < 5; ++j) {
            const int kt = wave + j;
            if (u.m0 - 128 + 32 * kt >= 0) {
                const LAS unsigned char* kb = lds + P2_KIMG + kt * 4096 + r32 * 128;
#pragma unroll
                for (int i = 0; i < 16; ++i) pt[j][i] = 0.f;
                bf16x8 kf[4];
#pragma unroll
                for (int d0 = 0; d0 < 4; ++d0) kf[d0] = *(const LAS bf16x8*)(kb + (((2 * d0 + hi) ^ (r32 & 7)) * 16));
#pragma unroll
                for (int d0 = 0; d0 < 4; ++d0) pt[j] = __builtin_amdgcn_mfma_f32_32x32x16_bf16(kf[d0], qf[d0], pt[j], 0, 0, 0);
            } else {
#pragma unroll
                for (int i = 0; i < 16; ++i) pt[j][i] = -1.0e30f;
            }
        }
#pragma unroll
        for (int i = 0; i < 16; ++i) { const int kk = (i & 3) + 8 * (i >> 2) + 4 * hi;
            pt[0][i] = (kk >= r32) ? pt[0][i] : -1.0e30f;
            pt[4][i] = (kk <= r32) ? pt[4][i] : -1.0e30f; }
        float mxa = fmaxf(pt[0][0], pt[1][0]), mxb = fmaxf(pt[2][0], pt[3][0]), mxc = pt[4][0];
#pragma unroll
        for (int i = 1; i < 16; ++i) { mxa = fmaxf(mxa, fmaxf(pt[0][i], pt[1][i])); mxb = fmaxf(mxb, fmaxf(pt[2][i], pt[3][i])); mxc = fmaxf(mxc, pt[4][i]); }
        const float m_run = swap32_max(fmaxf(fmaxf(mxa, mxb), mxc));
        float la = 0.f, lb = 0.f;
#pragma unroll
        for (int j = 0; j < 5; ++j)
#pragma unroll
            for (int i = 0; i < 16; i += 2) { pt[j][i] = __builtin_amdgcn_exp2f(pt[j][i] - m_run); pt[j][i + 1] = __builtin_amdgcn_exp2f(pt[j][i + 1] - m_run); la += pt[j][i]; lb += pt[j][i + 1]; }
        float l = la + lb;
        f32x16 o0, o1;
#pragma unroll
        for (int i = 0; i < 16; ++i) { o0[i] = 0.f; o1[i] = 0.f; }
#pragma unroll
        for (int j = 0; j < 5; ++j) {
            const int kt = wave + j;
            if (u.m0 - 128 + 32 * kt >= 0) {
                const bf16x8 pf0 = packp(pt[j], 0), pf1 = packp(pt[j], 8);
                const LAS unsigned char* vb = lds + P2_VIMG + kt * 4096 + vr_off;
#pragma unroll
                for (int ks = 0; ks < 2; ++ks) {
                    const s16x4 a0 = vtr(vb + ks * 1024), a1 = vtr(vb + ks * 1024 + 512), b0 = vtr(vb + 2048 + ks * 1024), b1 = vtr(vb + 2048 + ks * 1024 + 512);
                    const bf16x8 v0 = {a0[0], a0[1], a0[2], a0[3], a1[0], a1[1], a1[2], a1[3]}, v1 = {b0[0], b0[1], b0[2], b0[3], b1[0], b1[1], b1[2], b1[3]};
                    o0 = __builtin_amdgcn_mfma_f32_32x32x16_bf16(v0, ks ? pf1 : pf0, o0, 0, 0, 0);
                    o1 = __builtin_amdgcn_mfma_f32_32x32x16_bf16(v1, ks ? pf1 : pf0, o1, 0, 0, 0);
                }
            }
        }
        l = swap32_sum(l);
        const float inv = 1.0f / l;
        const size_t token = u.tokbase + (size_t)(u.m0 + 32 * wave + r32) * u.dil + u.r;
        bf16* obase = (u.p == 2 ? op2 : op01 + (size_t)u.p * MTOK * AW) + u.h * 64 + (lane & 7) * 8;
#pragma unroll
        for (int g4 = 0; g4 < 4; ++g4) {
            u32x2 wa, wb;
            wa.x = pg8::cvt_pk_bf16(o0[4 * g4] * inv, o0[4 * g4 + 1] * inv); wa.y = pg8::cvt_pk_bf16(o0[4 * g4 + 2] * inv, o0[4 * g4 + 3] * inv);
            wb.x = pg8::cvt_pk_bf16(o1[4 * g4] * inv, o1[4 * g4 + 1] * inv); wb.y = pg8::cvt_pk_bf16(o1[4 * g4 + 2] * inv, o1[4 * g4 + 3] * inv);
            *(LAS u32x2*)(stage + r32 * 128 + ((g4 ^ (r32 & 7)) * 16) + 8 * hi) = wa;
            *(LAS u32x2*)(stage + r32 * 128 + (((4 + g4) ^ (r32 & 7)) * 16) + 8 * hi) = wb;
        }
        asm volatile("" ::: "memory");
#pragma unroll
        for (int j = 0; j < 4; ++j) { const int row = (lane >> 3) + 8 * j;
            const u32x4 v = *(const LAS u32x4*)(stage + row * 128 + (((lane & 7) ^ (row & 7)) * 16));
            *(u32x4*)(obase + (u.tokbase + (size_t)(u.m0 + 32 * wave + row) * u.dil + u.r) * AW) = v; }
        if (hi == 0) lse[((size_t)u.p * MTOK + token) * 8 + u.h] = m_run + __builtin_amdgcn_logf(l);
    }
#undef P2A_ISSUE
#undef P2A_IDX
}
struct P3Tok { float l0, l1, l2; u32x4 a0, a1, a2, bg, cg0, xc0, cg1, xc1, cg2, xc2; };
__device__ __forceinline__ void p3_load(P3Tok& k, const bf16* proj, const bf16* op01, const bf16* op2, const float* lse, int token, int lane) {
    const int hh = lane >> 3, c0 = 8 * lane, t = token & (SEQ - 1); const bf16* prow = proj + (size_t)token * CONVP; const u32x4 z = {0u, 0u, 0u, 0u};
    k.l0 = __builtin_nontemporal_load(lse + (size_t)token * 8 + hh); k.l1 = __builtin_nontemporal_load(lse + ((size_t)MTOK + token) * 8 + hh); k.l2 = __builtin_nontemporal_load(lse + ((size_t)2 * MTOK + token) * 8 + hh);
    k.a0 = __builtin_nontemporal_load((const u32x4*)(op01 + (size_t)token * AW + c0)); k.a1 = __builtin_nontemporal_load((const u32x4*)(op01 + ((size_t)MTOK + token) * AW + c0)); k.a2 = __builtin_nontemporal_load((const u32x4*)(op2 + (size_t)token * AW + c0));
    k.bg = *(const u32x4*)(prow + c0); k.cg0 = *(const u32x4*)(prow + 512 + c0); k.xc0 = *(const u32x4*)(prow + 1024 + c0);
    k.cg1 = t >= 1 ? *(const u32x4*)(prow - CONVP + 512 + c0) : z; k.xc1 = t >= 1 ? *(const u32x4*)(prow - CONVP + 1024 + c0) : z;
    k.cg2 = t >= 2 ? *(const u32x4*)(prow - 2 * CONVP + 512 + c0) : z; k.xc2 = t >= 2 ? *(const u32x4*)(prow - 2 * CONVP + 1024 + c0) : z;
}
__device__ __forceinline__ void p3_compute(const P3Tok& k, const float* conv_w, const float* g_a, const float* g_c, bf16* merged, int token, int lane) {
    const int c0 = 8 * lane;
    const float mx = fmaxf(k.l0, fmaxf(k.l1, k.l2));
    float w0 = __builtin_amdgcn_exp2f(k.l0 - mx), w1 = __builtin_amdgcn_exp2f(k.l1 - mx), w2 = __builtin_amdgcn_exp2f(k.l2 - mx);
    const float winv = 1.0f / (w0 + w1 + w2); w0 *= winv; w1 *= winv; w2 *= winv;
    float a0[8], a1[8], a2[8], bg[8], cg0[8], xc0[8], cg1[8], xc1[8], cg2[8], xc2[8];
    unpack8(k.a0, a0); unpack8(k.a1, a1); unpack8(k.a2, a2); unpack8(k.bg, bg); unpack8(k.cg0, cg0); unpack8(k.xc0, xc0); unpack8(k.cg1, cg1); unpack8(k.xc1, xc1); unpack8(k.cg2, cg2); unpack8(k.xc2, xc2);
    float y[8], yc[8]; float ss = 0.f, sc = 0.f;
#pragma unroll
    for (int e = 0; e < 8; ++e) { y[e] = w0 * a0[e] + w1 * a1[e] + w2 * a2[e]; ss += y[e] * y[e];
        const float cw0 = conv_w[c0 + e], cw1 = conv_w[512 + c0 + e], cw2 = conv_w[1024 + c0 + e];
        yc[e] = bg[e] * (cw0 * (cg2[e] * xc2[e]) + cw1 * (cg1[e] * xc1[e]) + cw2 * (cg0[e] * xc0[e])); sc += yc[e] * yc[e]; }
#pragma unroll
    for (int o = 1; o < 64; o <<= 1) { ss += __shfl_xor(ss, o); sc += __shfl_xor(sc, o); }
    const float rs = 1.0f / sqrtf(ss * (1.0f / 512.0f) + EPS), rc = 1.0f / sqrtf(sc * (1.0f / 512.0f) + EPS);
    u32x4 o, oc;
#pragma unroll
    for (int i = 0; i < 4; ++i) { o[i] = pk2(y[2 * i] * rs * g_a[c0 + 2 * i], y[2 * i + 1] * rs * g_a[c0 + 2 * i + 1]); oc[i] = pk2(yc[2 * i] * rc * g_c[c0 + 2 * i], yc[2 * i + 1] * rc * g_c[c0 + 2 * i + 1]); }
    *(u32x4*)(merged + (size_t)token * 1024 + c0) = o; *(u32x4*)(merged + (size_t)token * 1024 + 512 + c0) = oc;
}
__device__ __forceinline__ void p3_merge(const bf16* proj, const bf16* op01, const bf16* op2, const float* lse, const float* conv_w, const float* g_a, const float* g_c, bf16* merged, int gw, int NGW, int lane) {
#pragma unroll 1
    for (int token = gw; token < MTOK; token += 2 * NGW) {
        const int tok2 = token + NGW; const bool has2 = tok2 < MTOK;
        P3Tok k0, k1;
        p3_load(k0, proj, op01, op2, lse, token, lane); p3_load(k1, proj, op01, op2, lse, has2 ? tok2 : token, lane);
        p3_compute(k0, conv_w, g_a, g_c, merged, token, lane);
        if (has2) p3_compute(k1, conv_w, g_a, g_c, merged, tok2, lane);
    }
}
__device__ __forceinline__ void p8_final(float* out, const float* g, int gw, int NGW, int lane) {
    for (int m = gw; m < MTOK; m += NGW) {
        f32x4* xr = (f32x4*)(out + (size_t)m * 1024) + lane; const f32x4* gr = (const f32x4*)g + lane;
        f32x4 v[4]; float s = 0.f;
#pragma unroll
        for (int j = 0; j < 4; ++j) { v[j] = xr[64 * j]; s += (v[j][0] * v[j][0] + v[j][1] * v[j][1]) + (v[j][2] * v[j][2] + v[j][3] * v[j][3]); }
        const float rs = 1.0f / sqrtf(wave_sum(s) * (1.0f / 1024.0f) + EPS);
#pragma unroll
        for (int j = 0; j < 4; ++j) xr[64 * j] = v[j] * rs * gr[64 * j];
    }
}

#define RLX_AGENT __ATOMIC_RELAXED, __HIP_MEMORY_SCOPE_AGENT
#define XB_TMO      128
#define XB_XCNT(j)  (256  + 64 * (j))
#define XB_XSUB(j)  (1280 + 64 * (j))
#define XB_XGEN(j)  (2304 + 64 * (j))
#define XB_TOP      3328
#define XB_TOPGEN   3392
#define XCD_BAR_WORDS 3456
#define XB_SPIN_CAP (1u << 18)

__device__ __forceinline__ unsigned xb_ld(unsigned* p)              { return __hip_atomic_load(p, __ATOMIC_RELAXED, __HIP_MEMORY_SCOPE_AGENT); }
__device__ __forceinline__ unsigned xb_add(unsigned* p, unsigned v) { return __hip_atomic_fetch_add(p, v, __ATOMIC_RELAXED, __HIP_MEMORY_SCOPE_AGENT); }
__device__ __forceinline__ unsigned xb_xcc_id() { return (unsigned)__builtin_amdgcn_s_getreg((3 << 11) | 20) & 0xFu; }
#define XB_SPIN(cond, bar) do { unsigned _sp = 0; while (cond) { __builtin_amdgcn_s_sleep(1); \
    if ((++_sp & 255u) == 0u) { if (xb_ld(&(bar)[XB_TMO])) break; if (_sp > XB_SPIN_CAP) { atomicAdd(&(bar)[XB_TMO], 1u); break; } } } } while (0)

struct XcdBarrier {
    unsigned* bar; unsigned x;
    volatile LAS unsigned* st;
};

__device__ __forceinline__ XcdBarrier xcd_barrier_post(unsigned* bar, volatile LAS unsigned* st) {
    XcdBarrier b; b.bar = bar; b.x = xb_xcc_id(); b.st = st;
    if (threadIdx.x == 0) (void)xb_add(&bar[XB_XCNT(b.x)], 1u);
    return b;
}
__device__ __forceinline__ void xcd_barrier_complete(unsigned* bar, unsigned x, unsigned& nloc, unsigned& nx) {
    const unsigned G = gridDim.x * gridDim.y * gridDim.z;
    unsigned sum, cnt, mine, sp = 0u;
    for (;;) {
        sum = 0u; cnt = 0u; mine = 0u;
#pragma unroll
        for (unsigned j = 0; j < 16; ++j) { const unsigned c = xb_ld(&bar[XB_XCNT(j)]); sum += c; cnt += (c > 0u) ? 1u : 0u; mine = (j == x) ? c : mine; }
        if (sum == G) break;
        __builtin_amdgcn_s_sleep(1);
        if ((++sp & 255u) == 0u) { if (xb_ld(&bar[XB_TMO])) break; if (sp > XB_SPIN_CAP) { atomicAdd(&bar[XB_TMO], 1u); break; } }
    }
    nloc = mine > 0u ? mine : 1u; nx = cnt > 0u ? cnt : 1u;
}

__device__ __forceinline__ void xcd_barrier(const XcdBarrier& b) {
    asm volatile("s_waitcnt vmcnt(0)" ::: "memory");
    __syncthreads();
    if (threadIdx.x == 0) {
        unsigned* bar = b.bar;
        __builtin_amdgcn_s_waitcnt(0);
        unsigned nloc = b.st[0], nx = b.st[1];
        if (nloc == 0u) { xcd_barrier_complete(bar, b.x, nloc, nx); b.st[0] = nloc; b.st[1] = nx; }
        const unsigned old = xb_add(&bar[XB_XSUB(b.x)], 1u);
        const unsigned gen = old / nloc;
        if (old + 1u == (gen + 1u) * nloc) {
            __builtin_amdgcn_fence(__ATOMIC_RELEASE, "agent");
            asm volatile("s_waitcnt vmcnt(0)" ::: "memory");
            const unsigned og = xb_add(&bar[XB_TOP], 1u);
            const unsigned tg = og / nx;
            if (og + 1u == (tg + 1u) * nx) xb_add(&bar[XB_TOPGEN], 1u);
            else XB_SPIN(xb_ld(&bar[XB_TOPGEN]) == tg, bar);
            __builtin_amdgcn_fence(__ATOMIC_ACQUIRE, "agent");
            xb_add(&bar[XB_XGEN(b.x)], 1u);
            asm volatile("s_waitcnt vmcnt(0)" ::: "memory");
        } else {
            XB_SPIN(xb_ld(&bar[XB_XGEN(b.x)]) == gen, bar);
            __builtin_amdgcn_fence(__ATOMIC_ACQUIRE, "agent");
            asm volatile("s_waitcnt vmcnt(0)" ::: "memory");
        }
    }
    __syncthreads();
}
constexpr int NPHASE = 10;
constexpr int CW_PANEL = 4096;
#ifndef DUP_PHASE
#define DUP_PHASE -1
#endif
#define NREP(k) ((k) == DUP_PHASE ? 2 : 1)
__global__ void __launch_bounds__(NWAVES * 64, 2) mega(Args a) {
    extern __shared__ __attribute__((aligned(16))) unsigned char lds_raw[];
    LAS unsigned char* lds = (LAS unsigned char*)lds_raw;
    const int wave = __builtin_amdgcn_readfirstlane((int)threadIdx.x >> 6);
#define LANE() ({ int t_ = threadIdx.x; asm volatile("" : "+v"(t_)); t_ & 63; })
    const int G = gridDim.x, bx = blockIdx.x;
    const int gw = bx * NWAVES + wave, NGW = G * NWAVES;
    unsigned char* ws = a.ws;
    const int lo = a.ph_lo, hi = a.ph_hi;
    if (lo < 0) cg::this_grid().sync();
    volatile LAS unsigned* MISC = (volatile LAS unsigned*)(lds + XCH_OFF + 8192);
    if (threadIdx.x < 64) MISC[threadIdx.x] = 0u;
    __syncthreads();
    XcdBarrier bar; bar.bar = (unsigned*)ws; bar.x = 0; bar.st = nullptr;
    if (hi - lo > 1) bar = xcd_barrier_post((unsigned*)ws, MISC + 8);
#define IN(k) (lo <= (k) && (k) < hi)
#define SEAM(k) do { if (IN(k) && IN((k) + 1)) xcd_barrier(bar); } while (0)
    bf16* const H1 = (bf16*)(ws + WS_H1); bf16* const PROJ = (bf16*)(ws + WS_PROJ); bf16* const MRG = (bf16*)(ws + WS_MRG); bf16* const HID = (bf16*)(ws + WS_HID);
    bf16* const KV = (bf16*)(ws + WS_KV); bf16* const MT = (bf16*)(ws + WS_MT); bf16* const NT = (bf16*)(ws + WS_NT);
    float* const SS1 = (float*)(ws + WS_SS1); float* const SS2 = (float*)(ws + WS_SS2);

    enum { PH_PRO = 0, PH_PROJ, PH_ATTN, PH_MERGE, PH_WOUT, PH_S, PH_PN, PH_UP, PH_DOWN, PH_FINAL };
    bf16* const QKVH = (bf16*)(ws + WS_QKV); bf16* const OP01 = (bf16*)(ws + WS_OP01); bf16* const OP2 = (bf16*)(ws + WS_OP2); float* const LSE = (float*)(ws + WS_LSE);
    if (IN(PH_PRO)) for (int rep = 0; rep < NREP(PH_PRO); ++rep) { p0_prologue(a, lds, gw, NGW, wave, LANE()); __syncthreads(); }
    SEAM(PH_PRO);
    if (IN(PH_PROJ)) for (int rep = 0; rep < NREP(PH_PROJ); ++rep) {
        { pg8::Gemm g{1024, 1024, 1024}; SchedStd S; S.init(H1, 1024, ws + WS_WIN, 1024, MTOK, INC, G, bx); pg8::EpiProj E{PROJ, QKVH, 0.125f * LOG2E};
          pg8::gemm_phase<pg8::EpiProj, SchedStd, true, true>(lds, g, S, E); }
    }
    SEAM(PH_PROJ);
    if (IN(PH_ATTN)) for (int rep = 0; rep < NREP(PH_ATTN); ++rep) {
        { pg8::Gemm g{1024, 1024, 1024}; SchedStd S; S.init(ws + WS_MEMN, 1024, ws + WS_WKV, 1024, MMEM, 2048, G, bx); pg8::EpiStore E{KV, 2048, 0, 1.0f};
          pg8::gemm_phase<pg8::EpiStore, SchedStd, true, true>(lds, g, S, E); }
        { int t_ = threadIdx.x; asm volatile("" : "+v"(t_)); p2a_attn(QKVH, OP01, OP2, LSE, lds, G, bx, wave, t_); }
    }
    SEAM(PH_ATTN);
    if (IN(PH_MERGE)) for (int rep = 0; rep < NREP(PH_MERGE); ++rep) {
        int k256 = 256; asm volatile("" : "+s"(k256));
        { pg8::Gemm g{k256, 2048, 1024}; SchedMt S{G, bx, (const char*)KV, (const char*)(ws + WS_WQS)}; pg8::EpiStore E{MT, 1024, 0, 1.0f};
          pg8::gemm_phase<pg8::EpiStore, SchedMt, true, true>(lds, g, S, E); }
        { pg8::Gemm g{k256, 1024, 2048}; SchedNt S{G, bx, (const char*)KV, (const char*)(ws + WS_WO)}; pg8::EpiStore E{NT, 1024, 0, 1.0f};
          pg8::gemm_phase<pg8::EpiStore, SchedNt, true, true>(lds, g, S, E); }
        p3_merge(PROJ, OP01, OP2, LSE, a.in[I_CONVW], a.in[I_GATT], a.in[I_GCONV], MRG, gw, NGW, LANE());
    }
    SEAM(PH_MERGE);
    if (IN(PH_WOUT)) for (int rep = 0; rep < NREP(PH_WOUT); ++rep) { pg8::Gemm g{1024, 1024, 1024}; SchedStd S; S.init(MRG, 1024, ws + WS_WOUT, 1024, MTOK, 1024, G, bx); pg8::EpiResid<false> E{a.in[I_X], nullptr, H1, SS1};
        pg8::gemm_phase<pg8::EpiResid<false>, SchedStd, false, true>(lds, g, S, E); }
    SEAM(PH_WOUT);
    if (IN(PH_S)) for (int rep = 0; rep < NREP(PH_S); ++rep) { pg8::Gemm g{1024, 1024, 1024}; SchedStd S; S.init(H1, 1024, MT, 1024, MTOK, 1024, G, bx, 4, (size_t)1024 * 1024 * 2); pg8::EpiSoftmax E{SS1, PROJ, (LAS float*)(lds + XCH_OFF)};
        pg8::gemm_phase<pg8::EpiSoftmax, SchedStd, true, true>(lds, g, S, E); }
    SEAM(PH_S);
    if (IN(PH_PN)) for (int rep = 0; rep < NREP(PH_PN); ++rep) { pg8::Gemm g{1024, 1024, 1024}; SchedStd S; S.init(PROJ, 1024, NT, 1024, MTOK, 1024, G, bx, 4, (size_t)1024 * 1024 * 2); pg8::EpiResid<true> E{H1, nullptr, MRG, SS2};
        pg8::gemm_phase<pg8::EpiResid<true>, SchedStd, true, true>(lds, g, S, E); }
    SEAM(PH_PN);
    if (IN(PH_UP)) for (int rep = 0; rep < NREP(PH_UP); ++rep) { pg8::Gemm g{1024, 1024, 1024}; SchedStd S; S.init(MRG, 1024, ws + WS_WUP, 1024, MTOK, FF, G, bx); pg8::EpiRelu2 E{SS2, HID, HIDP};
        pg8::gemm_phase<pg8::EpiRelu2, SchedStd, true, true>(lds, g, S, E); }
    SEAM(PH_UP);
    const bool fuse_final = (G == 256) && IN(PH_DOWN) && IN(PH_FINAL);
    if (IN(PH_DOWN)) for (int rep = 0; rep < NREP(PH_DOWN); ++rep) { pg8::Gemm g{4096, HIDP, 4096}; SchedStd S; S.init(HID, HIDP, ws + WS_WDN, 4096, MTOK, 1024, G, bx);
        if (fuse_final) { pg8::EpiFinal E{MRG, a.out, a.in[I_GFIN], (unsigned*)(ws + WS_SS1), (unsigned*)ws + CW_PANEL, (LAS float*)(lds + XCH_OFF)};
            pg8::gemm_phase<pg8::EpiFinal, SchedStd, true, true>(lds, g, S, E); }
        else { pg8::EpiResid<true> E{MRG, a.out, nullptr, nullptr};
            pg8::gemm_phase<pg8::EpiResid<true>, SchedStd, true, true>(lds, g, S, E); } }
    if (!fuse_final) {
        SEAM(PH_DOWN);
        if (IN(PH_FINAL)) p8_final(a.out, a.in[I_GFIN], gw, NGW, LANE());
    }
#undef IN
#undef SEAM
}

extern "C" void kernel_launch(void* const* d_in, const int* in_sizes, int n_in, void* d_out, int out_size, void* d_ws, size_t ws_size, hipStream_t stream) {
    static int grid = 0;
    if (grid == 0) {
        if (n_in != 17 || in_sizes[0] != MTOK * DM || out_size != MTOK * DM || ws_size < WS_END) { fprintf(stderr, "kernel_launch: unexpected shapes (n_in %d, in0 %d, out %d, ws %zu); nothing launched\n", n_in, n_in > 0 ? in_sizes[0] : -1, out_size, ws_size); grid = -1; return; }
        int dev = 0, cus = 0, per_cu = 0;
        if (hipGetDevice(&dev) != hipSuccess || hipDeviceGetAttribute(&cus, hipDeviceAttributeMultiprocessorCount, dev) != hipSuccess) { grid = -1; return; }
        if (hipFuncSetAttribute((const void*)mega, hipFuncAttributeMaxDynamicSharedMemorySize, LDS_BYTES) != hipSuccess) { fprintf(stderr, "kernel_launch: hipFuncSetAttribute failed\n"); grid = -1; return; }
        if (hipOccupancyMaxActiveBlocksPerMultiprocessor(&per_cu, (const void*)mega, NWAVES * 64, LDS_BYTES) != hipSuccess || per_cu < 1) { fprintf(stderr, "kernel_launch: occupancy query says %d\n", per_cu); per_cu = 1; }
        (void)hipGetLastError();
        grid = cus * per_cu;
    }
    if (grid < 0) return;
    Args a{};
    for (int i = 0; i < 17; ++i) a.in[i] = (const float*)d_in[i];
    a.out = (float*)d_out; a.ws = (unsigned char*)d_ws;
#if N_LAUNCHES == 1
    if (hipMemsetAsync(d_ws, 0, 65536, stream) != hipSuccess) { fprintf(stderr, "kernel_launch: hipMemsetAsync failed\n"); return; }
    a.ph_lo = 0; a.ph_hi = NPHASE;
    void* args[] = {&a};
    hipError_t e = hipLaunchCooperativeKernel((const void*)mega, dim3(grid), dim3(NWAVES * 64), args, LDS_BYTES, stream);
    if (e != hipSuccess) fprintf(stderr, "kernel_launch: cooperative launch failed: %s (grid %d)\n", hipGetErrorString(e), grid);
#else
    for (int li = 0; li < NPHASE; ++li) { a.ph_lo = li; a.ph_hi = li + 1; hipLaunchKernelGGL(mega, dim3(grid), dim3(NWAVES * 64), LDS_BYTES, stream, a); }
#endif
}
```

```cpp
#include <hip/hip_runtime.h>
#include <hip/hip_cooperative_groups.h>
#include <cstdio>
#include <cstdint>
namespace cg = cooperative_groups;

#ifndef N_LAUNCHES
#define N_LAUNCHES 1
#endif

namespace pg8 {
#define PG8_LAS __attribute__((address_space(3)))
typedef unsigned short bf16_t;
typedef short bf16x8 __attribute__((ext_vector_type(8)));
typedef float f32x4 __attribute__((ext_vector_type(4)));
typedef unsigned u32x4 __attribute__((ext_vector_type(4)));
constexpr int BM = 256, BK = 64, HALF = 128, HTB = HALF * BK * 2  , STAGE_BYTES = 8 * HTB, NXCD = 8, WGM = 8;

__host__ __device__ __forceinline__ int lds_byte(int r, int c) { const int st = (r >> 4) * 2 + (c >> 5), rr = r & 15, cc = c & 31, ob = rr * 64 + cc * 2; return st * 1024 + (ob ^ (((ob >> 9) & 1) << 5)); }
__host__ __device__ __forceinline__ void stage_rc(int b, int& R, int& C) { const int st = b / 1024, sb = b % 1024, swz = sb ^ (((sb >> 9) & 1) << 5); R = (st >> 1) * 16 + swz / 64; C = (st & 1) * 32 + (swz % 64) / 2; }
__host__ __device__ __forceinline__ int perm32(int rho) { const int n = rho >> 4, i = rho & 15; return 8 * (i >> 2) + 4 * n + (i & 3); }

struct Unit { int pm, pn; const char* a; const char* b; };
struct Gemm { int K, lda, ldb; };

struct StaticOrder {
    int nM, nN, nwg, G, c;
    __host__ __device__ void init(int M, int N, int G_, int c_) { nM = M / BM; nN = N / BM; nwg = nM * nN; G = G_; c = c_; }
    __host__ __device__ bool next(int i, Unit& u) const {
        const long L = (long)i * G + c; if (L >= nwg) return false;
        int wgid = (int)L; { const int q = nwg / NXCD, r = nwg % NXCD, xcd = wgid % NXCD, off = wgid / NXCD; wgid = (xcd < r ? xcd * (q + 1) : r * (q + 1) + (xcd - r) * q) + off; }
        const int nig = WGM * nN, gid = wgid / nig, fm = gid * WGM, gsz = (nM - fm) < WGM ? (nM - fm) : WGM;
        u.pm = fm + ((wgid % nig) % gsz); u.pn = (wgid % nig) / gsz; return true;
    }
};
__device__ __forceinline__ unsigned cvt_pk_bf16(float lo, float hi) { unsigned r; asm volatile("v_cvt_pk_bf16_f32 %0, %1, %2" : "=v"(r) : "v"(lo), "v"(hi)); return r; }

__device__ __forceinline__ u32x4 pack8(f32x4 v0, f32x4 v1) { u32x4 w; w.x = cvt_pk_bf16(v0[0], v0[1]); w.y = cvt_pk_bf16(v0[2], v0[3]); w.z = cvt_pk_bf16(v1[0], v1[1]); w.w = cvt_pk_bf16(v1[2], v1[3]); return w; }
__device__ __forceinline__ float sum16(const float* sp) { const f32x4 a = *(const f32x4*)sp, b = *(const f32x4*)(sp + 4), c = *(const f32x4*)(sp + 8), d = *(const f32x4*)(sp + 12);
    return ((a[0] + a[1]) + (a[2] + a[3])) + ((b[0] + b[1]) + (b[2] + b[3])) + ((c[0] + c[1]) + (c[2] + c[3])) + ((d[0] + d[1]) + (d[2] + d[3])); }

#define WT_RSRC(p) __builtin_amdgcn_make_buffer_rsrc((void*)(p), 0, 0x7ffffff0, 0x00020000)
__device__ __forceinline__ void st16wt(__amdgpu_buffer_rsrc_t r, size_t elem_off, u32x4 w) { __builtin_amdgcn_raw_buffer_store_b128(w, r, (unsigned)(elem_off * 2), 0,   16); }
__device__ __forceinline__ void row_scales(const float* SS, int row0, int fq, float (&rs)[2][4]) {
    f32x4 t[2][4];
#pragma unroll
    for (int ai = 0; ai < 2; ++ai)
#pragma unroll
        for (int m = 0; m < 4; ++m) t[ai][m] = *(const f32x4*)(SS + (size_t)(row0 + ai * HALF + m * 16) * 16 + fq * 4);
#pragma unroll
    for (int ai = 0; ai < 2; ++ai)
#pragma unroll
        for (int m = 0; m < 4; ++m) { float s = (t[ai][m][0] + t[ai][m][1]) + (t[ai][m][2] + t[ai][m][3]); s += __shfl_xor(s, 16); s += __shfl_xor(s, 32); rs[ai][m] = __builtin_amdgcn_rsqf(s * (1.0f / 1024.0f) + 1e-6f); }
}
struct EpiStore {
    static constexpr bool PERM = true, AFTER_DRAIN = false;
    bf16_t* O; int ldc; int npn_scaled; float scale0;
    __device__ __forceinline__ void operator()(f32x4 (&acc)[2][2][4][2], const Unit& u, int wr, int wc, int fr, int fq) const {
        const int row0 = u.pm * BM + wr * 64 + fr, col0 = u.pn * BM + wc * 32 + 8 * fq;
        const float sc = (u.pn < npn_scaled) ? scale0 : 1.0f;
        const __amdgpu_buffer_rsrc_t ors = WT_RSRC(O);
#pragma unroll
        for (int ai = 0; ai < 2; ++ai)
#pragma unroll
            for (int m = 0; m < 4; ++m) { const size_t ro = (size_t)(row0 + ai * HALF + m * 16) * ldc + col0;
#pragma unroll
                for (int bj = 0; bj < 2; ++bj) st16wt(ors, ro + bj * HALF, pack8(acc[ai][bj][m][0] * sc, acc[ai][bj][m][1] * sc)); }
    }
};
struct EpiProj {
    static constexpr bool PERM = true, AFTER_DRAIN = false;
    bf16_t* PC; bf16_t* QKV; float scale0;
    __device__ __forceinline__ void operator()(f32x4 (&acc)[2][2][4][2], const Unit& u, int wr, int wc, int fr, int fq) const {
        const int row0 = u.pm * BM + wr * 64 + fr;
        const __amdgpu_buffer_rsrc_t prs = WT_RSRC(PC), qrs = WT_RSRC(QKV);
        if (u.pn >= 6) {
            const int col0 = (u.pn - 6) * BM + wc * 32 + 8 * fq;
#pragma unroll
            for (int ai = 0; ai < 2; ++ai)
#pragma unroll
                for (int m = 0; m < 4; ++m) { const size_t ro = (size_t)(row0 + ai * HALF + m * 16) * 1536 + col0;
#pragma unroll
                    for (int bj = 0; bj < 2; ++bj) __builtin_amdgcn_raw_buffer_store_b128(pack8(acc[ai][bj][m][0], acc[ai][bj][m][1]), prs, (unsigned)((ro + bj * HALF) * 2), 0, 18); }
        } else {
            const float sc = (u.pn < 2) ? scale0 : 1.0f;
            const int which = u.pn >> 1, d = (wc & 1) * 32 + 8 * fq;
            const size_t base = (size_t)which * 32768 * 512 + d;
#pragma unroll
            for (int ai = 0; ai < 2; ++ai)
#pragma unroll
                for (int m = 0; m < 4; ++m) { const int row = row0 + ai * HALF + m * 16;
#pragma unroll
                    for (int bj = 0; bj < 2; ++bj) { const int h = 4 * (u.pn & 1) + 2 * bj + (wc >> 1);
                        st16wt(qrs, base + ((size_t)((row >> 12) * 8 + h) * 4096 + (row & 4095)) * 64, pack8(acc[ai][bj][m][0] * sc, acc[ai][bj][m][1] * sc)); } }
        }
    }
};
template <bool BASE_BF16> struct EpiResid {
    static constexpr bool PERM = true, AFTER_DRAIN = false;
    const void* base; float* out; bf16_t* xb; float* SS;
    __device__ __forceinline__ void operator()(f32x4 (&acc)[2][2][4][2], const Unit& u, int wr, int wc, int fr, int fq) const {
        const int row0 = u.pm * BM + wr * 64 + fr, col0 = u.pn * BM + wc * 32 + 8 * fq;
        const __amdgpu_buffer_rsrc_t xrs = WT_RSRC(xb);
#pragma unroll
        for (int ai = 0; ai < 2; ++ai) {
            u32x4 wb[4][2]; f32x4 fb[4][2][2];
#pragma unroll
            for (int m = 0; m < 4; ++m)
#pragma unroll
                for (int bj = 0; bj < 2; ++bj) { const size_t off = (size_t)(row0 + ai * HALF + m * 16) * 1024 + col0 + bj * HALF;
                    if (BASE_BF16) wb[m][bj] = *(const u32x4*)((const bf16_t*)base + off);
                    else { fb[m][bj][0] = *(const f32x4*)((const float*)base + off); fb[m][bj][1] = *(const f32x4*)((const float*)base + off + 4); } }
#pragma unroll
            for (int m = 0; m < 4; ++m) { const int row = row0 + ai * HALF + m * 16; float ss = 0.f;
#pragma unroll
                for (int bj = 0; bj < 2; ++bj) { const size_t off = (size_t)row * 1024 + col0 + bj * HALF;
                    f32x4 b0, b1;
                    if (BASE_BF16) { const u32x4 w = wb[m][bj];
                        b0 = (f32x4){__uint_as_float(w.x << 16), __uint_as_float(w.x & 0xffff0000u), __uint_as_float(w.y << 16), __uint_as_float(w.y & 0xffff0000u)};
                        b1 = (f32x4){__uint_as_float(w.z << 16), __uint_as_float(w.z & 0xffff0000u), __uint_as_float(w.w << 16), __uint_as_float(w.w & 0xffff0000u)}; }
                    else { b0 = fb[m][bj][0]; b1 = fb[m][bj][1]; }
                    const f32x4 v0 = acc[ai][bj][m][0] + b0, v1 = acc[ai][bj][m][1] + b1;
                    if (out) { *(f32x4*)(out + off) = v0; *(f32x4*)(out + off + 4) = v1; }
                    if (xb) st16wt(xrs, off, pack8(v0, v1));
                    ss += ((v0[0] * v0[0] + v0[1] * v0[1]) + (v0[2] * v0[2] + v0[3] * v0[3])) + ((v1[0] * v1[0] + v1[1] * v1[1]) + (v1[2] * v1[2] + v1[3] * v1[3])); }
                if (SS) { ss += __shfl_xor(ss, 16); ss += __shfl_xor(ss, 32); if (fq == 0) SS[(size_t)row * 16 + u.pn * 4 + wc] = ss; } }
            asm volatile("" ::: "memory");
        }
    }
};
struct EpiRelu2 {
    static constexpr bool PERM = true, AFTER_DRAIN = false;
    const float* SS; bf16_t* O; int ldo;
    __device__ __forceinline__ void operator()(f32x4 (&acc)[2][2][4][2], const Unit& u, int wr, int wc, int fr, int fq) const {
        const int row0 = u.pm * BM + wr * 64 + fr, col0 = u.pn * BM + wc * 32 + 8 * fq;
        float rsv[2][4]; row_scales(SS, row0, fq, rsv);
#pragma unroll
        for (int ai = 0; ai < 2; ++ai)
#pragma unroll
            for (int m = 0; m < 4; ++m) { const int row = row0 + ai * HALF + m * 16;
                const float rs = rsv[ai][m];
                bf16_t* rowp = O + (size_t)row * ldo + col0;
#pragma unroll
                for (int bj = 0; bj < 2; ++bj) { f32x4 v0 = acc[ai][bj][m][0] * rs, v1 = acc[ai][bj][m][1] * rs;
#pragma unroll
                    for (int e = 0; e < 4; ++e) { const float a = fmaxf(v0[e], 0.f), b = fmaxf(v1[e], 0.f); v0[e] = a * a; v1[e] = b * b; }
                    __builtin_nontemporal_store(pack8(v0, v1), (u32x4*)(rowp + bj * HALF)); } }
    }
};
struct EpiSoftmax {
    static constexpr bool PERM = true, AFTER_DRAIN = false;
    const float* SS; bf16_t* P; PG8_LAS float* xch;
    __device__ __forceinline__ void operator()(f32x4 (&acc)[2][2][4][2], const Unit& u, int wr, int wc, int fr, int fq) const {
        const int row0 = u.pm * BM + wr * 64 + fr, col0 = u.pn * BM + wc * 32 + 8 * fq;
        const __amdgpu_buffer_rsrc_t prs = WT_RSRC(P);
        float mw[2][4];
        float rsv[2][4]; row_scales(SS, row0, fq, rsv);
#pragma unroll
        for (int ai = 0; ai < 2; ++ai)
#pragma unroll
            for (int m = 0; m < 4; ++m) { const int rl = ai * HALF + wr * 64 + m * 16 + fr;
                const float sc = rsv[ai][m] * (0.0625f * 1.4426950408889634f);
                float mx = -3.0e38f;
#pragma unroll
                for (int bj = 0; bj < 2; ++bj)
#pragma unroll
                    for (int n = 0; n < 2; ++n) { f32x4 v = acc[ai][bj][m][n] * sc; acc[ai][bj][m][n] = v; mx = fmaxf(mx, fmaxf(fmaxf(v[0], v[1]), fmaxf(v[2], v[3]))); }
                mx = fmaxf(mx, __shfl_xor(mx, 16)); mx = fmaxf(mx, __shfl_xor(mx, 32));
                float l = 0.f;
#pragma unroll
                for (int bj = 0; bj < 2; ++bj)
#pragma unroll
                    for (int n = 0; n < 2; ++n) { f32x4 v = acc[ai][bj][m][n];
#pragma unroll
                        for (int e = 0; e < 4; ++e) { v[e] = __builtin_amdgcn_exp2f(v[e] - mx); l += v[e]; }
                        acc[ai][bj][m][n] = v; }
                l += __shfl_xor(l, 16); l += __shfl_xor(l, 32);
                mw[ai][m] = mx;
                if (fq == 0) { xch[rl * 8 + wc * 2] = mx; xch[rl * 8 + wc * 2 + 1] = l; } }
        asm volatile("s_waitcnt lgkmcnt(0)\n\ts_barrier" ::: "memory");
#pragma unroll
        for (int ai = 0; ai < 2; ++ai)
#pragma unroll
            for (int m = 0; m < 4; ++m) { const int row = row0 + ai * HALF + m * 16; const int rl = ai * HALF + wr * 64 + m * 16 + fr;
                const f32x4 x0 = *(const PG8_LAS f32x4*)(xch + rl * 8), x1 = *(const PG8_LAS f32x4*)(xch + rl * 8 + 4);
                const float M = fmaxf(fmaxf(x0[0], x0[2]), fmaxf(x1[0], x1[2]));
                const float L = (x0[1] * __builtin_amdgcn_exp2f(x0[0] - M) + x0[3] * __builtin_amdgcn_exp2f(x0[2] - M)) + (x1[1] * __builtin_amdgcn_exp2f(x1[0] - M) + x1[3] * __builtin_amdgcn_exp2f(x1[2] - M));
                const float fac = __builtin_amdgcn_exp2f(mw[ai][m] - M) * __builtin_amdgcn_rcpf(L);
                bf16_t* rowp = P + (size_t)row * 1024 + col0;
#pragma unroll
                for (int bj = 0; bj < 2; ++bj) st16wt(prs, (size_t)row * 1024 + col0 + bj * HALF, pack8(acc[ai][bj][m][0] * fac, acc[ai][bj][m][1] * fac)); }
        asm volatile("s_waitcnt lgkmcnt(0)" ::: "memory");
    }
};

struct EpiFinal {
    static constexpr bool PERM = true, AFTER_DRAIN = false;
    const bf16_t* base; float* out; const float* gain; unsigned* slots; unsigned* cnt; PG8_LAS float* tab;
    __device__ __forceinline__ void operator()(f32x4 (&acc)[2][2][4][2], const Unit& u, int wr, int wc, int fr, int fq) const {
        const int row0 = u.pm * BM + wr * 64 + fr, col0 = u.pn * BM + wc * 32 + 8 * fq;
        const int lane = fr + 16 * fq, wid = wr * 4 + wc;
        PG8_LAS float* Ptab = tab; PG8_LAS float* Stab = tab + 1024;
#pragma unroll
        for (int ai = 0; ai < 2; ++ai)
#pragma unroll
            for (int m = 0; m < 4; ++m) { const int row = row0 + ai * HALF + m * 16; float ss = 0.f;
#pragma unroll
                for (int bj = 0; bj < 2; ++bj) { const size_t off = (size_t)row * 1024 + col0 + bj * HALF;
                    const u32x4 w = *(const u32x4*)(base + off);
                    const f32x4 b0 = (f32x4){__uint_as_float(w.x << 16), __uint_as_float(w.x & 0xffff0000u), __uint_as_float(w.y << 16), __uint_as_float(w.y & 0xffff0000u)};
                    const f32x4 b1 = (f32x4){__uint_as_float(w.z << 16), __uint_as_float(w.z & 0xffff0000u), __uint_as_float(w.w << 16), __uint_as_float(w.w & 0xffff0000u)};
                    const f32x4 v0 = acc[ai][bj][m][0] + b0, v1 = acc[ai][bj][m][1] + b1; acc[ai][bj][m][0] = v0; acc[ai][bj][m][1] = v1;
                    ss += ((v0[0] * v0[0] + v0[1] * v0[1]) + (v0[2] * v0[2] + v0[3] * v0[3])) + ((v1[0] * v1[0] + v1[1] * v1[1]) + (v1[2] * v1[2] + v1[3] * v1[3])); }
                ss += __shfl_xor(ss, 16); ss += __shfl_xor(ss, 32);
                if (fq == 0) Ptab[(ai * HALF + wr * 64 + m * 16 + fr) * 4 + wc] = ss; }
        asm volatile("s_waitcnt lgkmcnt(0)\n\ts_barrier" ::: "memory");
        const int rowl = wid * 32 + (lane & 31);
        if (lane < 32) { const f32x4 p = *(const PG8_LAS f32x4*)(Ptab + rowl * 4);
            __hip_atomic_store(slots + ((size_t)(u.pm * BM + rowl) * 4 + u.pn), __float_as_uint((p[0] + p[1]) + (p[2] + p[3])), __ATOMIC_RELAXED, __HIP_MEMORY_SCOPE_AGENT); }
        asm volatile("s_waitcnt vmcnt(0)" ::: "memory");
        if (lane == 0) __hip_atomic_fetch_add(cnt + 64 * u.pm, 1u, __ATOMIC_RELAXED, __HIP_MEMORY_SCOPE_AGENT);
        if (wid == 0) {
            unsigned sp = 0;
            while ((unsigned)__builtin_amdgcn_readfirstlane(__hip_atomic_load(cnt + 64 * u.pm, __ATOMIC_RELAXED, __HIP_MEMORY_SCOPE_AGENT)) < 32u) { __builtin_amdgcn_s_sleep(2); if (++sp > (1u << 22)) break; }
            __builtin_amdgcn_fence(__ATOMIC_ACQUIRE, "agent");
        }
        asm volatile("s_waitcnt vmcnt(0) lgkmcnt(0)\n\ts_barrier" ::: "memory");
        if (lane < 32) { const unsigned* sl = slots + (size_t)(u.pm * BM + rowl) * 4; float t = 0.f;
#pragma unroll
            for (int k = 0; k < 4; ++k) t += __uint_as_float(__hip_atomic_load(sl + k, __ATOMIC_RELAXED, __HIP_MEMORY_SCOPE_AGENT));
            Stab[rowl] = 1.0f / sqrtf(t * (1.0f / 1024.0f) + 1e-6f); }
        asm volatile("s_waitcnt vmcnt(0) lgkmcnt(0)\n\ts_barrier" ::: "memory");
        f32x4 g[2][2];
#pragma unroll
        for (int bj = 0; bj < 2; ++bj) { g[bj][0] = *(const f32x4*)(gain + col0 + bj * HALF); g[bj][1] = *(const f32x4*)(gain + col0 + bj * HALF + 4); }
#pragma unroll
        for (int ai = 0; ai < 2; ++ai)
#pragma unroll
            for (int m = 0; m < 4; ++m) { const int row = row0 + ai * HALF + m * 16; const float rs = Stab[ai * HALF + wr * 64 + m * 16 + fr];
#pragma unroll
                for (int bj = 0; bj < 2; ++bj) { const size_t off = (size_t)row * 1024 + col0 + bj * HALF;
                    *(f32x4*)(out + off) = acc[ai][bj][m][0] * rs * g[bj][0]; *(f32x4*)(out + off + 4) = acc[ai][bj][m][1] * rs * g[bj][1]; } }
        asm volatile("s_waitcnt lgkmcnt(0)" ::: "memory");
    }
};

template <class Epi, class Sched, bool ALIGN_EPI = false, bool SP2 = false>
__device__ __forceinline__ void gemm_phase(PG8_LAS unsigned char* lds, const Gemm g, const Sched& S, const Epi& E) {
    int tid = threadIdx.x; asm volatile("" : "+v"(tid));
    const int wid = __builtin_amdgcn_readfirstlane(tid >> 6), lane = tid & 63, wr = wid >> 2, wc = wid & 3, fr = lane & 15, fq = lane >> 4;
    const int K = g.K, nt = K / BK;
    unsigned voffA[2], voffB[2];
#pragma unroll
    for (int i = 0; i < 2; ++i) { int R, C; stage_rc(tid * 16 + i * 8192, R, C); const int Rb = Epi::PERM ? ((R & ~31) + perm32(R & 31)) : R;
        voffA[i] = (unsigned)(R * g.lda + C) * 2u; voffB[i] = (unsigned)(Rb * g.ldb + C) * 2u; }
    const size_t kstep = (size_t)(BK * 2);
    const size_t hstepA = (size_t)HALF * g.lda * 2, hstepB = (size_t)HALF * g.ldb * 2;
        const unsigned ldsw = (unsigned)wid * 1024u;
    const int aoff = lds_byte(wr * 64 + fr, fq * 8), boff = lds_byte(wc * 32 + fr, fq * 8);
#define PG8_SA(b, h) (((b) * 2 + (h)) * HTB)
#define PG8_SB(b, h) ((4 + (b) * 2 + (h)) * HTB)
#define PG8_STAGE(bufoff, gbase, voff) do { _Pragma("unroll") for (int _i = 0; _i < 2; ++_i) \
        __builtin_amdgcn_global_load_lds((const unsigned*)((const char*)(gbase) + (voff)[_i]), (PG8_LAS unsigned*)(lds + (bufoff) + ldsw + _i * 8192), 16, 0, 0); } while (0)
#define PG8_LDA(dst, b, h) do { _Pragma("unroll") for (int m = 0; m < 4; ++m) _Pragma("unroll") for (int k = 0; k < 2; ++k) dst[m][k] = *(const PG8_LAS bf16x8*)(lds + PG8_SA(b, h) + aoff + m * 2048 + k * 1024); } while (0)
#define PG8_LDB(dst, b, h) do { _Pragma("unroll") for (int n = 0; n < 2; ++n) _Pragma("unroll") for (int k = 0; k < 2; ++k) dst[n][k] = *(const PG8_LAS bf16x8*)(lds + PG8_SB(b, h) + boff + n * 2048 + k * 1024); } while (0)
#define PG8_MMA(ai, bj, At, Bt) do { __builtin_amdgcn_s_setprio(1); _Pragma("unroll") for (int m = 0; m < 4; ++m) _Pragma("unroll") for (int n = 0; n < 2; ++n) _Pragma("unroll") for (int k = 0; k < 2; ++k) \
        acc[ai][bj][m][n] = __builtin_amdgcn_mfma_f32_16x16x32_bf16(Bt[n][k], At[m][k], acc[ai][bj][m][n], 0, 0, 0); __builtin_amdgcn_s_setprio(0); } while (0)
#define PG8_WAIT_V(n) asm volatile("s_waitcnt vmcnt(" #n ")" ::: "memory")
#define PG8_WAIT_L(n) asm volatile("s_waitcnt lgkmcnt(" #n ")" ::: "memory")
#define PG8_BAR __builtin_amdgcn_s_barrier()
#define PG8_SCHED __builtin_amdgcn_sched_barrier(0)
    Unit cur, nxt; int ui = 0;
    if (!S.next(0, cur)) return;
    f32x4 acc[2][2][4][2];
#pragma unroll
    for (int a = 0; a < 2; ++a)
#pragma unroll
        for (int b = 0; b < 2; ++b)
#pragma unroll
            for (int m = 0; m < 4; ++m)
#pragma unroll
                for (int n = 0; n < 2; ++n) acc[a][b][m][n] = (f32x4){0.f, 0.f, 0.f, 0.f};
    bf16x8 At[4][2], B0[2][2], B1[2][2];
    const char* cA = cur.a; const char* cB = cur.b;
    S.a_ready(cur);
    if constexpr (SP2) {
        PG8_STAGE(PG8_SB(0, 0), cB, voffB); PG8_STAGE(PG8_SB(0, 1), cB + hstepB, voffB); PG8_STAGE(PG8_SA(0, 0), cA, voffA); PG8_STAGE(PG8_SA(0, 1), cA + hstepA, voffA);
        if (wr == 1) PG8_BAR;
        PG8_WAIT_V(2); PG8_BAR;
        PG8_STAGE(PG8_SB(1, 0), cB + kstep, voffB); PG8_STAGE(PG8_SA(1, 0), cA + kstep, voffA); PG8_STAGE(PG8_SB(1, 1), cB + hstepB + kstep, voffB);
        PG8_WAIT_V(6); PG8_BAR;
    } else {
        PG8_STAGE(PG8_SB(0, 0), cB, voffB); PG8_STAGE(PG8_SA(0, 0), cA, voffA); PG8_STAGE(PG8_SB(0, 1), cB + hstepB, voffB); PG8_STAGE(PG8_SA(0, 1), cA + hstepA, voffA);
        if (wr == 1) PG8_BAR;
        PG8_WAIT_V(4); PG8_BAR;
        PG8_STAGE(PG8_SB(1, 0), cB + kstep, voffB); PG8_STAGE(PG8_SA(1, 0), cA + kstep, voffA); PG8_STAGE(PG8_SB(1, 1), cB + hstepB + kstep, voffB);
        PG8_WAIT_V(6); PG8_BAR;
    }
    for (;;) {
        const bool has_next = S.next(ui + 1, nxt);
        const char* nA = has_next ? nxt.a : cA; const char* nB = has_next ? nxt.b : cB;
        for (int t = 0; t < nt; t += 2) {
            const bool last = (t == nt - 2);
            const char* a1 = cA + (size_t)(t + 1) * kstep;
            const char* a2 = last ? nA : cA + (size_t)(t + 2) * kstep; const char* b2 = last ? nB : cB + (size_t)(t + 2) * kstep;
            const char* a3 = a2 + kstep; const char* b3 = b2 + kstep;
            if (last && has_next) S.a_ready(nxt);
            if constexpr (SP2) {
            PG8_LDB(B0, 0, 0); PG8_LDB(B1, 0, 1); PG8_SCHED; PG8_LDA(At, 0, 0); PG8_STAGE(PG8_SA(1, 1), a1 + hstepA, voffA);
            PG8_WAIT_V(8); PG8_WAIT_L(0); PG8_BAR; PG8_MMA(0, 0, At, B0); PG8_MMA(0, 1, At, B1); PG8_BAR; PG8_SCHED;
            PG8_LDA(At, 0, 1); PG8_STAGE(PG8_SB(0, 0), b2, voffB); PG8_STAGE(PG8_SB(0, 1), b2 + hstepB, voffB); PG8_STAGE(PG8_SA(0, 0), a2, voffA);
            PG8_WAIT_V(8); PG8_WAIT_L(0); PG8_BAR; PG8_MMA(1, 0, At, B0); PG8_MMA(1, 1, At, B1); PG8_BAR; PG8_SCHED;
            PG8_LDB(B0, 1, 0); PG8_LDB(B1, 1, 1); PG8_SCHED; PG8_LDA(At, 1, 0); PG8_STAGE(PG8_SA(0, 1), a2 + hstepA, voffA);
            PG8_WAIT_V(8); PG8_WAIT_L(0); PG8_BAR; PG8_MMA(0, 0, At, B0); PG8_MMA(0, 1, At, B1); PG8_BAR; PG8_SCHED;
            PG8_LDA(At, 1, 1); PG8_STAGE(PG8_SB(1, 0), b3, voffB); PG8_STAGE(PG8_SB(1, 1), b3 + hstepB, voffB); PG8_STAGE(PG8_SA(1, 0), a3, voffA);
            PG8_WAIT_V(8); PG8_WAIT_L(0); PG8_BAR; PG8_MMA(1, 0, At, B0); PG8_MMA(1, 1, At, B1); PG8_BAR; PG8_SCHED;
            } else {
            PG8_LDB(B0, 0, 0); PG8_SCHED; PG8_LDA(At, 0, 0); PG8_STAGE(PG8_SA(1, 1), a1 + hstepA, voffA);
            PG8_WAIT_L(8); PG8_BAR; PG8_WAIT_L(0); PG8_MMA(0, 0, At, B0); PG8_BAR; PG8_SCHED;
            PG8_LDB(B1, 0, 1); PG8_STAGE(PG8_SB(0, 0), b2, voffB);
            PG8_BAR; PG8_WAIT_L(0); PG8_MMA(0, 1, At, B1); PG8_BAR;
            PG8_LDA(At, 0, 1); PG8_STAGE(PG8_SA(0, 0), a2, voffA);
            PG8_BAR; PG8_WAIT_L(0); PG8_MMA(1, 0, At, B0); PG8_BAR; PG8_SCHED;
            PG8_STAGE(PG8_SB(0, 1), b2 + hstepB, voffB);
            PG8_WAIT_V(6); PG8_BAR; PG8_MMA(1, 1, At, B1); PG8_BAR;
            PG8_LDB(B0, 1, 0); PG8_SCHED; PG8_LDA(At, 1, 0); PG8_STAGE(PG8_SA(0, 1), a2 + hstepA, voffA);
            PG8_WAIT_L(8); PG8_BAR; PG8_WAIT_L(0); PG8_MMA(0, 0, At, B0); PG8_BAR; PG8_SCHED;
            PG8_LDB(B1, 1, 1); PG8_STAGE(PG8_SB(1, 0), b3, voffB);
            PG8_BAR; PG8_WAIT_L(0); PG8_MMA(0, 1, At, B1); PG8_BAR;
            PG8_LDA(At, 1, 1); PG8_STAGE(PG8_SA(1, 0), a3, voffA);
            PG8_BAR; PG8_WAIT_L(0); PG8_MMA(1, 0, At, B0); PG8_BAR; PG8_SCHED;
            PG8_STAGE(PG8_SB(1, 1), b3 + hstepB, voffB);
            PG8_WAIT_V(6); PG8_BAR; PG8_MMA(1, 1, At, B1); PG8_BAR;
            }
        }
        if constexpr (ALIGN_EPI) { if (wr == 0) PG8_BAR; }
        if constexpr (!Epi::AFTER_DRAIN) { E(acc, cur, wr, wc, fr, fq); S.done(cur); }
        if (!has_next) break;
#pragma unroll
        for (int a = 0; a < 2; ++a)
#pragma unroll
            for (int b = 0; b < 2; ++b)
#pragma unroll
                for (int m = 0; m < 4; ++m)
#pragma unroll
                    for (int n = 0; n < 2; ++n) acc[a][b][m][n] = (f32x4){0.f, 0.f, 0.f, 0.f};
        cur = nxt; cA = nA; cB = nB; ++ui;
        if constexpr (ALIGN_EPI) { if (wr == 1) PG8_BAR; }
    }
    PG8_WAIT_V(0);
    if constexpr (!ALIGN_EPI) { if (wr == 0) PG8_BAR; }
    PG8_BAR;
    if constexpr (Epi::AFTER_DRAIN) { E.fused(acc, cur, wr, wc, fr, fq, lds, wid, lane); S.done(cur); }
#undef PG8_SA
#undef PG8_SB
#undef PG8_STAGE
#undef PG8_LDA
#undef PG8_LDB
#undef PG8_MMA
#undef PG8_WAIT_V
#undef PG8_WAIT_L
#undef PG8_BAR
#undef PG8_SCHED
}}

struct SchedStd {
    pg8::StaticOrder so; const char* A; const char* B; size_t tA, tB, bstride; int bshift;
    __device__ __forceinline__ void init(const void* A_, int lda, const void* B_, int ldb, int M, int N, int G, int c, int bshift_ = 30, size_t bstride_ = 0) {
        so.init(M, N, G, c); A = (const char*)A_; B = (const char*)B_; tA = (size_t)256 * lda * 2; tB = (size_t)256 * ldb * 2; bshift = bshift_; bstride = bstride_; }
    __device__ __forceinline__ bool next(int i, pg8::Unit& u) const { if (!so.next(i, u)) return false; u.a = A + (size_t)u.pm * tA; u.b = B + (size_t)u.pn * tB + (size_t)(u.pm >> bshift) * bstride; return true; }
    __device__ __forceinline__ void a_ready(const pg8::Unit&) const {}
    __device__ __forceinline__ void done(const pg8::Unit&) const {}
};
struct SchedMt {
    int G, c; const char* KV; const char* WqS;
    __device__ __forceinline__ bool next(int i, pg8::Unit& u) const { const int L = i * G + c; if (L >= 128) return false; const int b = L >> 4, h = (L >> 2) & 3, pn = L & 3;
        u.pm = b * 4 + h; u.pn = pn; u.a = KV + ((size_t)(b * 256) * 2048 + h * 256) * 2; u.b = WqS + ((size_t)pn * 256 * 1024 + h * 256) * 2; return true; }
    __device__ __forceinline__ void a_ready(const pg8::Unit&) const {}
    __device__ __forceinline__ void done(const pg8::Unit&) const {}
};
struct SchedNt {
    int G, c; const char* KV; const char* WoT;
    __device__ __forceinline__ bool next(int i, pg8::Unit& u) const { const int L = i * G + ((c + G / 2) % G); if (L >= 128) return false; const int b = L >> 4, pmc = (L >> 2) & 3, h = L & 3;
        u.pm = b * 4 + pmc; u.pn = h; u.a = WoT + ((size_t)pmc * 256 * 1024 + h * 256) * 2; u.b = KV + ((size_t)(b * 256) * 2048 + 1024 + h * 256) * 2; return true; }
    __device__ __forceinline__ void a_ready(const pg8::Unit&) const {}
    __device__ __forceinline__ void done(const pg8::Unit&) const {}
};

constexpr int NB = 8, SEQ = 4096, DM = 1024, MTOK = NB * SEQ, MEMLEN = 256, MMEM = NB * MEMLEN, INC = 3072, FF = 4096, AW = 512;
constexpr float EPS = 1e-6f, LOG2E = 1.4426950408889634f;
constexpr int NWAVES = 8;
constexpr size_t MiB = 1u << 20;
constexpr size_t WS_WIN = 1 * MiB, WS_WOUT = 7 * MiB, WS_WQS = 9 * MiB, WS_WKV = 11 * MiB, WS_WO = 15 * MiB, WS_WUP = 17 * MiB, WS_WDN = 25 * MiB;
constexpr size_t WS_MEMN = 33 * MiB, WS_KV = 37 * MiB, WS_MT = 45 * MiB, WS_NT = 61 * MiB, WS_SS1 = 77 * MiB, WS_SS2 = 79 * MiB;
constexpr size_t WS_H1 = 96 * MiB;
constexpr size_t WS_PROJ = 160 * MiB;
constexpr size_t WS_QKV = 256 * MiB;
constexpr int CONVP = 1536;
constexpr int HIDP = 4096 + 64;
constexpr size_t WS_MRG = 358 * MiB;
constexpr size_t WS_HID = 96 * MiB;
constexpr size_t WS_LSE = 82 * MiB;
constexpr size_t WS_OP01 = 96 * MiB;
constexpr size_t WS_OP2 = 422 * MiB;
constexpr size_t WS_END = 454 * MiB;
static_assert(WS_HID + (size_t)MTOK * HIDP * 2 <= WS_MRG && WS_MRG + (size_t)MTOK * 1024 * 2 <= WS_OP2 && WS_OP2 + (size_t)MTOK * AW * 2 <= WS_END, "d_ws map");
constexpr int RING_BYTES = 131072, XCH_OFF = RING_BYTES, LDS_BYTES = RING_BYTES + 8192 + 4096;

#define LAS __attribute__((address_space(3)))
typedef unsigned short bf16;
typedef float f32x4 __attribute__((ext_vector_type(4)));
typedef unsigned u32x4 __attribute__((ext_vector_type(4)));
typedef unsigned u32x2 __attribute__((ext_vector_type(2)));
#define LDS_WAIT() asm volatile("s_waitcnt lgkmcnt(0)" ::: "memory")
__device__ __forceinline__ unsigned f2bf(float f) { unsigned u = __builtin_bit_cast(unsigned, f); return (u + 0x7fffu + ((u >> 16) & 1u)) >> 16; }
__device__ __forceinline__ unsigned pk2(float lo, float hi) { return f2bf(lo) | (f2bf(hi) << 16); }
__device__ __forceinline__ float bf2f(unsigned v) { return __uint_as_float(v << 16); }
__device__ __forceinline__ float wave_sum(float v) {
#pragma unroll
    for (int o = 1; o < 64; o <<= 1) v += __shfl_xor(v, o);
    return v;
}

__device__ __forceinline__ void p0_transpose_item(const float* W, int K, int N, bf16* WT, const float* gain, LAS float* scr, int item, int lane) {
    const int nblk = N / 32, kb = item / nblk, nb = item % nblk, k0 = 64 * kb, n0 = 32 * nb;
    f32x4 v[8];
#pragma unroll
    for (int i = 0; i < 8; ++i) v[i] = __builtin_nontemporal_load((const f32x4*)(W + (size_t)(k0 + 8 * i + (lane >> 3)) * N + n0 + 4 * (lane & 7)));
#pragma unroll
    for (int i = 0; i < 8; ++i) { const int kk = 8 * i + (lane >> 3); const float g = gain ? gain[k0 + kk] : 1.0f; LAS float* d = scr + kk * 33 + 4 * (lane & 7);
        d[0] = v[i][0] * g; d[1] = v[i][1] * g; d[2] = v[i][2] * g; d[3] = v[i][3] * g; }
    LDS_WAIT(); asm volatile("" ::: "memory");
    const int c = lane & 7;
#pragma unroll
    for (int j = 0; j < 4; ++j) { const int n = (lane >> 3) + 8 * j; const LAS float* s = scr + (8 * c) * 33 + n;
        u32x4 o; o.x = pk2(s[0 * 33], s[1 * 33]); o.y = pk2(s[2 * 33], s[3 * 33]); o.z = pk2(s[4 * 33], s[5 * 33]); o.w = pk2(s[6 * 33], s[7 * 33]);
        *(u32x4*)(WT + (size_t)(n0 + n) * K + k0 + 8 * c) = o; }
    LDS_WAIT(); asm volatile("" ::: "memory");
}
__device__ __forceinline__ void rms_row_to_bf16(const float* xrow, const float* g, bf16* orow, int lane) {
    const f32x4* xr = (const f32x4*)xrow + lane; const f32x4* gr = (const f32x4*)g + lane;
    f32x4 v[4]; float s = 0.f;
#pragma unroll
    for (int j = 0; j < 4; ++j) { v[j] = xr[64 * j]; s += (v[j][0] * v[j][0] + v[j][1] * v[j][1]) + (v[j][2] * v[j][2] + v[j][3] * v[j][3]); }
    const float rs = 1.0f / sqrtf(wave_sum(s) * (1.0f / 1024.0f) + EPS);
    u32x2* o8 = (u32x2*)orow + lane;
#pragma unroll
    for (int j = 0; j < 4; ++j) { const f32x4 gv = gr[64 * j]; u32x2 o; o.x = pk2(v[j][0] * rs * gv[0], v[j][1] * rs * gv[1]); o.y = pk2(v[j][2] * rs * gv[2], v[j][3] * rs * gv[3]); o8[64 * j] = o; }
}

struct Args { const float* in[17]; float* out; unsigned char* ws; int ph_lo, ph_hi; };
enum { I_X = 0, I_MEM, I_GMIX, I_WIN, I_CONVW, I_GATT, I_GCONV, I_WOUT, I_GX, I_GMEM, I_WQ, I_WKV, I_WO, I_GMLP, I_WUP, I_WDN, I_GFIN };

__device__ __forceinline__ void p0_rows(const Args& a, int gw, int NGW, int lane) {
    const float* X = a.in[I_X]; const float* g = a.in[I_GMIX]; bf16* H1 = (bf16*)(a.ws + WS_H1);
    const f32x4* gr = (const f32x4*)g + lane;
#pragma unroll 1
    for (int m = gw; m < MTOK; m += 2 * NGW) {
        const int m2 = m + NGW; const bool has2 = m2 < MTOK;
        const f32x4* x0 = (const f32x4*)(X + (size_t)m * 1024) + lane; const f32x4* x1 = (const f32x4*)(X + (size_t)(has2 ? m2 : m) * 1024) + lane;
        f32x4 v[4], w[4]; float s0 = 0.f, s1 = 0.f;
#pragma unroll
        for (int j = 0; j < 4; ++j) { v[j] = __builtin_nontemporal_load(x0 + 64 * j); w[j] = __builtin_nontemporal_load(x1 + 64 * j); }
#pragma unroll
        for (int j = 0; j < 4; ++j) { s0 += (v[j][0] * v[j][0] + v[j][1] * v[j][1]) + (v[j][2] * v[j][2] + v[j][3] * v[j][3]); s1 += (w[j][0] * w[j][0] + w[j][1] * w[j][1]) + (w[j][2] * w[j][2] + w[j][3] * w[j][3]); }
#pragma unroll
        for (int o = 1; o < 64; o <<= 1) { s0 += __shfl_xor(s0, o); s1 += __shfl_xor(s1, o); }
        const float r0 = 1.0f / sqrtf(s0 * (1.0f / 1024.0f) + EPS), r1 = 1.0f / sqrtf(s1 * (1.0f / 1024.0f) + EPS);
        u32x2* o0 = (u32x2*)(H1 + (size_t)m * 1024) + lane; u32x2* o1 = (u32x2*)(H1 + (size_t)m2 * 1024) + lane;
#pragma unroll
        for (int j = 0; j < 4; ++j) { const f32x4 gv = gr[64 * j]; u32x2 o; o.x = pk2(v[j][0] * r0 * gv[0], v[j][1] * r0 * gv[1]); o.y = pk2(v[j][2] * r0 * gv[2], v[j][3] * r0 * gv[3]); o0[64 * j] = o;
            if (has2) { u32x2 p; p.x = pk2(w[j][0] * r1 * gv[0], w[j][1] * r1 * gv[1]); p.y = pk2(w[j][2] * r1 * gv[2], w[j][3] * r1 * gv[3]); o1[64 * j] = p; } }
    }
}
__device__ __forceinline__ void p0_prologue(const Args& a, LAS unsigned char* lds, int gw, int NGW, int wave, int lane) {
    unsigned char* ws = a.ws;
    LAS float* scr = (LAS float*)(lds + wave * 16384);
    constexpr int I_IN = 16 * 96, I_OUT = 16 * 32, I_KV = 16 * 64, I_O = 16 * 32, I_UP = 16 * 128, I_DN = 64 * 32;
    constexpr int NITEMS = I_IN + I_OUT + I_KV + I_O + I_UP + I_DN;
    const bool rows_first = (wave & 1) != 0;
    if (rows_first) p0_rows(a, gw, NGW, lane);
    for (int it = gw; it < NITEMS; it += NGW) {
        int r = it;
        if (r < I_IN) { p0_transpose_item(a.in[I_WIN], 1024, 3072, (bf16*)(ws + WS_WIN), nullptr, scr, r, lane); continue; } r -= I_IN;
        if (r < I_OUT) { p0_transpose_item(a.in[I_WOUT], 1024, 1024, (bf16*)(ws + WS_WOUT), nullptr, scr, r, lane); continue; } r -= I_OUT;
        if (r < I_KV) { p0_transpose_item(a.in[I_WKV], 1024, 2048, (bf16*)(ws + WS_WKV), nullptr, scr, r, lane); continue; } r -= I_KV;
        if (r < I_O) { p0_transpose_item(a.in[I_WO], 1024, 1024, (bf16*)(ws + WS_WO), nullptr, scr, r, lane); continue; } r -= I_O;
        if (r < I_UP) { p0_transpose_item(a.in[I_WUP], 1024, 4096, (bf16*)(ws + WS_WUP), a.in[I_GMLP], scr, r, lane); continue; } r -= I_UP;
        p0_transpose_item(a.in[I_WDN], 4096, 1024, (bf16*)(ws + WS_WDN), nullptr, scr, r, lane);
    }
    for (int c = gw; c < 1024; c += NGW) { const float g = a.in[I_GX][c]; const f32x4* wr_ = (const f32x4*)(a.in[I_WQ] + (size_t)c * 1024) + lane; u32x2* o8 = (u32x2*)((bf16*)(ws + WS_WQS) + (size_t)c * 1024) + lane;
#pragma unroll
        for (int j = 0; j < 4; ++j) { const f32x4 v = wr_[64 * j]; u32x2 o; o.x = pk2(v[0] * g, v[1] * g); o.y = pk2(v[2] * g, v[3] * g); o8[64 * j] = o; } }
    for (int m = gw; m < MMEM; m += NGW) rms_row_to_bf16(a.in[I_MEM] + (size_t)m * 1024, a.in[I_GMEM], (bf16*)(ws + WS_MEMN) + (size_t)m * 1024, lane);
    if (!rows_first) p0_rows(a, gw, NGW, lane);
}

__device__ __forceinline__ void unpack8(const u32x4 w, float (&f)[8]) {
#pragma unroll
    for (int i = 0; i < 4; ++i) { f[2 * i] = __uint_as_float(w[i] << 16); f[2 * i + 1] = __uint_as_float(w[i] & 0xffff0000u); }
}
typedef float f32x16 __attribute__((ext_vector_type(16)));
typedef short bf16x8 __attribute__((ext_vector_type(8)));
typedef short s16x4 __attribute__((ext_vector_type(4)));
__device__ __forceinline__ float swap32_max(float v) { auto rr = __builtin_amdgcn_permlane32_swap(__float_as_uint(v), __float_as_uint(v), false, false); return fmaxf(__uint_as_float(rr[0]), __uint_as_float(rr[1])); }
__device__ __forceinline__ float swap32_sum(float v) { auto rr = __builtin_amdgcn_permlane32_swap(__float_as_uint(v), __float_as_uint(v), false, false); return __uint_as_float(rr[0]) + __uint_as_float(rr[1]); }
__device__ __forceinline__ s16x4 vtr(const LAS unsigned char* p) { return __builtin_bit_cast(s16x4, __builtin_amdgcn_ds_read_tr16_b64_v4i16((LAS s16x4*)p)); }
__device__ __forceinline__ bf16x8 packp(const f32x16& p, int b) { u32x4 w; w.x = pg8::cvt_pk_bf16(p[b], p[b + 1]); w.y = pg8::cvt_pk_bf16(p[b + 2], p[b + 3]); w.z = pg8::cvt_pk_bf16(p[b + 4], p[b + 5]); w.w = pg8::cvt_pk_bf16(p[b + 6], p[b + 7]); return __builtin_bit_cast(bf16x8, w); }

constexpr int P2_UNITS = 3072, P2_KIMG = 0, P2_VIMG = 49152, P2_STAGE = 98304;
struct P2Unit { const bf16* pb; int h, p, dil, r, m0; size_t tokbase; };
__device__ __forceinline__ P2Unit p2_decode(int L, const bf16* proj) {
    P2Unit u; const int xcd = L & 7, idx = L >> 3, b = idx / 48, rem = idx % 48, uu = rem & 15; u.p = rem >> 4; u.h = xcd;
    const int dsh = 2 * u.p; u.dil = 1 << dsh; const int chunk = uu & ((16 >> dsh) - 1); u.r = uu >> (4 - dsh); u.m0 = chunk * 256;
    u.pb = proj + (size_t)(b * 8 + u.h) * SEQ * 64; u.tokbase = (size_t)b * SEQ; return u;
}
constexpr size_t QKV_PLANE = (size_t)MTOK * AW;
__device__ __forceinline__ void p2a_attn(const bf16* proj, bf16* op01, bf16* op2, float* lse, LAS unsigned char* lds, int G, int bx, int wave, int tid) {
    const int lane = tid & 63, r32 = lane & 31, hi = lane >> 5;
    const int vr_off = (4 * hi + ((lane & 15) >> 2)) * 64 + ((lane >> 4) & 1) * 32 + (lane & 3) * 8;
    u32x4 kreg[6], vreg[6], qn[4];
    LAS unsigned char* stage = lds + P2_STAGE + wave * 4096;
#define P2A_ISSUE(LL) do { const P2Unit un = p2_decode((LL), proj); \
        _Pragma("unroll") for (int j = 0; j < 4; ++j) { const int row = (lane >> 3) + 8 * j; \
          qn[j] = *(const u32x4*)(un.pb + (size_t)((un.m0 + 32 * wave + row) * un.dil + un.r) * 64 + (lane & 7) * 8); } \
        _Pragma("unroll") for (int j = 0; j < 6; ++j) { const int q = tid + 512 * j, row = q >> 3, ch = q & 7; const int pos = max(un.m0 - 128 + row, 0); \
          const bf16* kp = un.pb + QKV_PLANE + (size_t)(pos * un.dil + un.r) * 64 + ch * 8; kreg[j] = *(const u32x4*)kp; vreg[j] = *(const u32x4*)(kp + QKV_PLANE); } } while (0)
    const int xcd_ = bx & 7, cl = bx >> 3;
    const bool g256 = (G == 256);
    const int ncl = g256 ? 32 : (G + 7 - xcd_) / 8;
    const int cnt = g256 ? (cl < 8 ? 9 : 13) : (384 - cl + ncl - 1) / ncl;
#define P2A_IDX(k) ((g256 && (k) >= 9) ? 288 + 24 * ((k) - 9) + (cl - 8) : ncl * (k) + cl)
    if (cnt > 0) P2A_ISSUE(P2A_IDX(0) * 8 + xcd_);
#pragma unroll 1
    for (int k = 0; k < cnt; ++k) {
        const int L = P2A_IDX(k) * 8 + xcd_;
        const P2Unit u = p2_decode(L, proj);
        __syncthreads();
#pragma unroll
        for (int j = 0; j < 6; ++j) { const int q = tid + 512 * j, row = q >> 3, ch = q & 7;
            *(LAS u32x4*)(lds + P2_KIMG + row * 128 + ((ch ^ (row & 7)) * 16)) = kreg[j];
            *(LAS u32x4*)(lds + P2_VIMG + (row >> 5) * 4096 + (ch >> 2) * 2048 + (row & 31) * 64 + (ch & 3) * 16) = vreg[j]; }
#pragma unroll
        for (int j = 0; j < 4; ++j) { const int row = (lane >> 3) + 8 * j; *(LAS u32x4*)(stage + row * 128 + (((lane & 7) ^ (row & 7)) * 16)) = qn[j]; }
        asm volatile("" ::: "memory");
        bf16x8 qf[4];
#pragma unroll
        for (int d0 = 0; d0 < 4; ++d0) qf[d0] = *(const LAS bf16x8*)(stage + r32 * 128 + (((2 * d0 + hi) ^ (r32 & 7)) * 16));
        __syncthreads();
        if (k + 1 < cnt) P2A_ISSUE(P2A_IDX(k + 1) * 8 + xcd_);
        f32x16 pt[5];
#pragma unroll
        for (int j = 0; j < 5; ++j) {
            const int kt = wave + j;
            if (u.m0 - 128 + 32 * kt >= 0) {
                const LAS unsigned char* kb = lds + P2_KIMG + kt * 4096 + r32 * 128;
#pragma unroll
                for (int i = 0; i < 16; ++i) pt[j][i] = 0.f;
                bf16x8 kf[4];
#pragma unroll
                for (int d0 = 0; d0 < 4; ++d0) kf[d0] = *(const LAS bf16x8*)(kb + (((2 * d0 + hi) ^ (r32 & 7)) * 16));
#pragma unroll
                for (int d0 = 0; d0 < 4; ++d0) pt[j] = __builtin_amdgcn_mfma_f32_32x32x16_bf16(kf[d0], qf[d0], pt[j], 0, 0, 0);
            } else {
#pragma unroll
                for (int i = 0; i < 16; ++i) pt[j][i] = -1.0e30f;
            }
        }
#pragma unroll
        for (int i = 0; i < 16; ++i) { const int kk = (i & 3) + 8 * (i >> 2) + 4 * hi;
            pt[0][i] = (kk >= r32) ? pt[0][i] : -1.0e30f;
            pt[4][i] = (kk <= r32) ? pt[4][i] : -1.0e30f; }
        float mxa = fmaxf(pt[0][0], pt[1][0]), mxb = fmaxf(pt[2][0], pt[3][0]), mxc = pt[4][0];
#pragma unroll
        for (int i = 1; i < 16; ++i) { mxa = fmaxf(mxa, fmaxf(pt[0][i], pt[1][i])); mxb = fmaxf(mxb, fmaxf(pt[2][i], pt[3][i])); mxc = fmaxf(mxc, pt[4][i]); }
        const float m_run = swap32_max(fmaxf(fmaxf(mxa, mxb), mxc));
        float la = 0.f, lb = 0.f;
#pragma unroll
        for (int j = 0; j < 5; ++j)
#pragma unroll
            for (int i = 0; i < 16; i += 2) { pt[j][i] = __builtin_amdgcn_exp2f(pt[j][i] - m_run); pt[j][i + 1] = __builtin_amdgcn_exp2f(pt[j][i + 1] - m_run); la += pt[j][i]; lb += pt[j][i + 1]; }
        float l = la + lb;
        f32x16 o0, o1;
#pragma unroll
        for (int i = 0; i < 16; ++i) { o0[i] = 0.f; o1[i] = 0.f; }
#pragma unroll
        for (int j = 0; j < 5; ++j) {
            const int kt = wave + j;
            if (u.m0 - 128 + 32 * kt >= 0) {
                const bf16x8 pf0 = packp(pt[j], 0), pf1 = packp(pt[j], 8);
                const LAS unsigned char* vb = lds + P2_VIMG + kt * 4096 + vr_off;
#pragma unroll
                for (int ks = 0; ks < 2; ++ks) {
                    const s16x4 a0 = vtr(vb + ks * 1024), a1 = vtr(vb + ks * 1024 + 512), b0 = vtr(vb + 2048 + ks * 1024), b1 = vtr(vb + 2048 + ks * 1024 + 512);
                    const bf16x8 v0 = {a0[0], a0[1], a0[2], a0[3], a1[0], a1[1], a1[2], a1[3]}, v1 = {b0[0], b0[1], b0[2], b0[3], b1[0], b1[1], b1[2], b1[3]};
                    o0 = __builtin_amdgcn_mfma_f32_32x32x16_bf16(v0, ks ? pf1 : pf0, o0, 0, 0, 0);
                    o1 = __builtin_amdgcn_mfma_f32_32x32x16_bf16(v1, ks ? pf1 : pf0, o1, 0, 0, 0);
                }
            }
        }
        l = swap32_sum(l);
        const float inv = 1.0f / l;
        const size_t token = u.tokbase + (size_t)(u.m0 + 32 * wave + r32) * u.dil + u.r;
        bf16* obase = (u.p == 2 ? op2 : op01 + (size_t)u.p * MTOK * AW) + u.h * 64 + (lane & 7) * 8;
#pragma unroll
        for (int g4 = 0; g4 < 4; ++g4) {
            u32x2 wa, wb;
            wa.x = pg8::cvt_pk_bf16(o0[4 * g4] * inv, o0[4 * g4 + 1] * inv); wa.y = pg8::cvt_pk_bf16(o0[4 * g4 + 2] * inv, o0[4 * g4 + 3] * inv);
            wb.x = pg8::cvt_pk_bf16(o1[4 * g4] * inv, o1[4 * g4 + 1] * inv); wb.y = pg8::cvt_pk_bf16(o1[4 * g4 + 2] * inv, o1[4 * g4 + 3] * inv);
            *(LAS u32x2*)(stage + r32 * 128 + ((g4 ^ (r32 & 7)) * 16) + 8 * hi) = wa;
            *(LAS u32x2*)(stage + r32 * 128 + (((4 + g4) ^ (r32 & 7)) * 16) + 8 * hi) = wb;
        }
        asm volatile("" ::: "memory");
#pragma unroll
        for (int j = 0; j < 4; ++j) { const int row = (lane >> 3) + 8 * j;
            const u32x4 v = *(const LAS u32x4*)(stage + row * 128 + (((lane & 7) ^ (row & 7)) * 16));
            *(u32x4*)(obase + (u.tokbase + (size_t)(u.m0 + 32 * wave + row) * u.dil + u.r) * AW) = v; }
        if (hi == 0) lse[((size_t)u.p * MTOK + token) * 8 + u.h] = m_run + __builtin_amdgcn_logf(l);
    }
#undef P2A_ISSUE
#undef P2A_IDX
}
struct P3Tok { float l0, l1, l2; u32x4 a0, a1, a2, bg, cg0, xc0, cg1, xc1, cg2, xc2; };
__device__ __forceinline__ void p3_load(P3Tok& k, const bf16* proj, const bf16* op01, const bf16* op2, const float* lse, int token, int lane) {
    const int hh = lane >> 3, c0 = 8 * lane, t = token & (SEQ - 1); const bf16* prow = proj + (size_t)token * CONVP; const u32x4 z = {0u, 0u, 0u, 0u};
    k.l0 = __builtin_nontemporal_load(lse + (size_t)token * 8 + hh); k.l1 = __builtin_nontemporal_load(lse + ((size_t)MTOK + token) * 8 + hh); k.l2 = __builtin_nontemporal_load(lse + ((size_t)2 * MTOK + token) * 8 + hh);
    k.a0 = __builtin_nontemporal_load((const u32x4*)(op01 + (size_t)token * AW + c0)); k.a1 = __builtin_nontemporal_load((const u32x4*)(op01 + ((size_t)MTOK + token) * AW + c0)); k.a2 = __builtin_nontemporal_load((const u32x4*)(op2 + (size_t)token * AW + c0));
    k.bg = *(const u32x4*)(prow + c0); k.cg0 = *(const u32x4*)(prow + 512 + c0); k.xc0 = *(const u32x4*)(prow + 1024 + c0);
    k.cg1 = t >= 1 ? *(const u32x4*)(prow - CONVP + 512 + c0) : z; k.xc1 = t >= 1 ? *(const u32x4*)(prow - CONVP + 1024 + c0) : z;
    k.cg2 = t >= 2 ? *(const u32x4*)(prow - 2 * CONVP + 512 + c0) : z; k.xc2 = t >= 2 ? *(const u32x4*)(prow - 2 * CONVP + 1024 + c0) : z;
}
__device__ __forceinline__ void p3_compute(const P3Tok& k, const float* conv_w, const float* g_a, const float* g_c, bf16* merged, int token, int lane) {
    const int c0 = 8 * lane;
    const float mx = fmaxf(k.l0, fmaxf(k.l1, k.l2));
    float w0 = __builtin_amdgcn_exp2f(k.l0 - mx), w1 = __builtin_amdgcn_exp2f(k.l1 - mx), w2 = __builtin_amdgcn_exp2f(k.l2 - mx);
    const float winv = 1.0f / (w0 + w1 + w2); w0 *= winv; w1 *= winv; w2 *= winv;
    float a0[8], a1[8], a2[8], bg[8], cg0[8], xc0[8], cg1[8], xc1[8], cg2[8], xc2[8];
    unpack8(k.a0, a0); unpack8(k.a1, a1); unpack8(k.a2, a2); unpack8(k.bg, bg); unpack8(k.cg0, cg0); unpack8(k.xc0, xc0); unpack8(k.cg1, cg1); unpack8(k.xc1, xc1); unpack8(k.cg2, cg2); unpack8(k.xc2, xc2);
    float y[8], yc[8]; float ss = 0.f, sc = 0.f;
#pragma unroll
    for (int e = 0; e < 8; ++e) { y[e] = w0 * a0[e] + w1 * a1[e] + w2 * a2[e]; ss += y[e] * y[e];
        const float cw0 = conv_w[c0 + e], cw1 = conv_w[512 + c0 + e], cw2 = conv_w[1024 + c0 + e];
        yc[e] = bg[e] * (cw0 * (cg2[e] * xc2[e]) + cw1 * (cg1[e] * xc1[e]) + cw2 * (cg0[e] * xc0[e])); sc += yc[e] * yc[e]; }
#pragma unroll
    for (int o = 1; o < 64; o <<= 1) { ss += __shfl_xor(ss, o); sc += __shfl_xor(sc, o); }
    const float rs = 1.0f / sqrtf(ss * (1.0f / 512.0f) + EPS), rc = 1.0f / sqrtf(sc * (1.0f / 512.0f) + EPS);
    u32x4 o, oc;
#pragma unroll
    for (int i = 0; i < 4; ++i) { o[i] = pk2(y[2 * i] * rs * g_a[c0 + 2 * i], y[2 * i + 1] * rs * g_a[c0 + 2 * i + 1]); oc[i] = pk2(yc[2 * i] * rc * g_c[c0 + 2 * i], yc[2 * i + 1] * rc * g_c[c0 + 2 * i + 1]); }
    *(u32x4*)(merged + (size_t)token * 1024 + c0) = o; *(u32x4*)(merged + (size_t)token * 1024 + 512 + c0) = oc;
}
__device__ __forceinline__ void p3_merge(const bf16* proj, const bf16* op01, const bf16* op2, const float* lse, const float* conv_w, const float* g_a, const float* g_c, bf16* merged, int gw, int NGW, int lane) {
#pragma unroll 1
    for (int token = gw; token < MTOK; token += 2 * NGW) {
        const int tok2 = token + NGW; const bool has2 = tok2 < MTOK;
        P3Tok k0, k1;
        p3_load(k0, proj, op01, op2, lse, token, lane); p3_load(k1, proj, op01, op2, lse, has2 ? tok2 : token, lane);
        p3_compute(k0, conv_w, g_a, g_c, merged, token, lane);
        if (has2) p3_compute(k1, conv_w, g_a, g_c, merged, tok2, lane);
    }
}
__device__ __forceinline__ void p8_final(float* out, const float* g, int gw, int NGW, int lane) {
    for (int m = gw; m < MTOK; m += NGW) {
        f32x4* xr = (f32x4*)(out + (size_t)m * 1024) + lane; const f32x4* gr = (const f32x4*)g + lane;
        f32x4 v[4]; float s = 0.f;
#pragma unroll
        for (int j = 0; j < 4; ++j) { v[j] = xr[64 * j]; s += (v[j][0] * v[j][0] + v[j][1] * v[j][1]) + (v[j][2] * v[j][2] + v[j][3] * v[j][3]); }
        const float rs = 1.0f / sqrtf(wave_sum(s) * (1.0f / 1024.0f) + EPS);
#pragma unroll
        for (int j = 0; j < 4; ++j) xr[64 * j] = v[j] * rs * gr[64 * j];
    }
}

#define RLX_AGENT __ATOMIC_RELAXED, __HIP_MEMORY_SCOPE_AGENT
#define XB_TMO      128
#define XB_XCNT(j)  (256  + 64 * (j))
#define XB_XSUB(j)  (1280 + 64 * (j))
#define XB_XGEN(j)  (2304 + 64 * (j))
#define XB_TOP      3328
#define XB_TOPGEN   3392
#define XCD_BAR_WORDS 3456
#define XB_SPIN_CAP (1u << 18)

__device__ __forceinline__ unsigned xb_ld(unsigned* p)              { return __hip_atomic_load(p, __ATOMIC_RELAXED, __HIP_MEMORY_SCOPE_AGENT); }
__device__ __forceinline__ unsigned xb_add(unsigned* p, unsigned v) { return __hip_atomic_fetch_add(p, v, __ATOMIC_RELAXED, __HIP_MEMORY_SCOPE_AGENT); }
__device__ __forceinline__ unsigned xb_xcc_id() { return (unsigned)__builtin_amdgcn_s_getreg((3 << 11) | 20) & 0xFu; }
#define XB_SPIN(cond, bar) do { unsigned _sp = 0; while (cond) { __builtin_amdgcn_s_sleep(1); \
    if ((++_sp & 255u) == 0u) { if (xb_ld(&(bar)[XB_TMO])) break; if (_sp > XB_SPIN_CAP) { atomicAdd(&(bar)[XB_TMO], 1u); break; } } } } while (0)

struct XcdBarrier {
    unsigned* bar; unsigned x;
    volatile LAS unsigned* st;
};

__device__ __forceinline__ XcdBarrier xcd_barrier_post(unsigned* bar, volatile LAS unsigned* st) {
    XcdBarrier b; b.bar = bar; b.x = xb_xcc_id(); b.st = st;
    if (threadIdx.x == 0) (void)xb_add(&bar[XB_XCNT(b.x)], 1u);
    return b;
}
__device__ __forceinline__ void xcd_barrier_complete(unsigned* bar, unsigned x, unsigned& nloc, unsigned& nx) {
    const unsigned G = gridDim.x * gridDim.y * gridDim.z;
    unsigned sum, cnt, mine, sp = 0u;
    for (;;) {
        sum = 0u; cnt = 0u; mine = 0u;
#pragma unroll
        for (unsigned j = 0; j < 16; ++j) { const unsigned c = xb_ld(&bar[XB_XCNT(j)]); sum += c; cnt += (c > 0u) ? 1u : 0u; mine = (j == x) ? c : mine; }
        if (sum == G) break;
        __builtin_amdgcn_s_sleep(1);
        if ((++sp & 255u) == 0u) { if (xb_ld(&bar[XB_TMO])) break; if (sp > XB_SPIN_CAP) { atomicAdd(&bar[XB_TMO], 1u); break; } }
    }
    nloc = mine > 0u ? mine : 1u; nx = cnt > 0u ? cnt : 1u;
}

__device__ __forceinline__ void xcd_barrier(const XcdBarrier& b) {
    asm volatile("s_waitcnt vmcnt(0)" ::: "memory");
    __syncthreads();
    if (threadIdx.x == 0) {
        unsigned* bar = b.bar;
        __builtin_amdgcn_s_waitcnt(0);
        unsigned nloc = b.st[0], nx = b.st[1];
        if (nloc == 0u) { xcd_barrier_complete(bar, b.x, nloc, nx); b.st[0] = nloc; b.st[1] = nx; }
        const unsigned old = xb_add(&bar[XB_XSUB(b.x)], 1u);
        const unsigned gen = old / nloc;
        if (old + 1u == (gen + 1u) * nloc) {
            __builtin_amdgcn_fence(__ATOMIC_RELEASE, "agent");
            asm volatile("s_waitcnt vmcnt(0)" ::: "memory");
            const unsigned og = xb_add(&bar[XB_TOP], 1u);
            const unsigned tg = og / nx;
            if (og + 1u == (tg + 1u) * nx) xb_add(&bar[XB_TOPGEN], 1u);
            else XB_SPIN(xb_ld(&bar[XB_TOPGEN]) == tg, bar);
            __builtin_amdgcn_fence(__ATOMIC_ACQUIRE, "agent");
            xb_add(&bar[XB_XGEN(b.x)], 1u);
            asm volatile("s_waitcnt vmcnt(0)" ::: "memory");
        } else {
            XB_SPIN(xb_ld(&bar[XB_XGEN(b.x)]) == gen, bar);
            __builtin_amdgcn_fence(__ATOMIC_ACQUIRE, "agent");
            asm volatile("s_waitcnt vmcnt(0)" ::: "memory");
        }
    }
    __syncthreads();
}
constexpr int NPHASE = 10;
constexpr int CW_PANEL = 4096;
#ifndef DUP_PHASE
#define DUP_PHASE -1
#endif
#define NREP(k) ((k) == DUP_PHASE ? 2 : 1)
__global__ void __launch_bounds__(NWAVES * 64, 2) mega(Args a) {
    extern __shared__ __attribute__((aligned(16))) unsigned char lds_raw[];
    LAS unsigned char* lds = (LAS unsigned char*)lds_raw;
    const int wave = __builtin_amdgcn_readfirstlane((int)threadIdx.x >> 6);
#define LANE() ({ int t_ = threadIdx.x; asm volatile("" : "+v"(t_)); t_ & 63; })
    const int G = gridDim.x, bx = blockIdx.x;
    const int gw = bx * NWAVES + wave, NGW = G * NWAVES;
    unsigned char* ws = a.ws;
    const int lo = a.ph_lo, hi = a.ph_hi;
    if (lo < 0) cg::this_grid().sync();
    volatile LAS unsigned* MISC = (volatile LAS unsigned*)(lds + XCH_OFF + 8192);
    if (threadIdx.x < 64) MISC[threadIdx.x] = 0u;
    __syncthreads();
    XcdBarrier bar; bar.bar = (unsigned*)ws; bar.x = 0; bar.st = nullptr;
    if (hi - lo > 1) bar = xcd_barrier_post((unsigned*)ws, MISC + 8);
#define IN(k) (lo <= (k) && (k) < hi)
#define SEAM(k) do { if (IN(k) && IN((k) + 1)) xcd_barrier(bar); } while (0)
    bf16* const H1 = (bf16*)(ws + WS_H1); bf16* const PROJ = (bf16*)(ws + WS_PROJ); bf16* const MRG = (bf16*)(ws + WS_MRG); bf16* const HID = (bf16*)(ws + WS_HID);
    bf16* const KV = (bf16*)(ws + WS_KV); bf16* const MT = (bf16*)(ws + WS_MT); bf16* const NT = (bf16*)(ws + WS_NT);
    float* const SS1 = (float*)(ws + WS_SS1); float* const SS2 = (float*)(ws + WS_SS2);

    enum { PH_PRO = 0, PH_PROJ, PH_ATTN, PH_MERGE, PH_WOUT, PH_S, PH_PN, PH_UP, PH_DOWN, PH_FINAL };
    bf16* const QKVH = (bf16*)(ws + WS_QKV); bf16* const OP01 = (bf16*)(ws + WS_OP01); bf16* const OP2 = (bf16*)(ws + WS_OP2); float* const LSE = (float*)(ws + WS_LSE);
    if (IN(PH_PRO)) for (int rep = 0; rep < NREP(PH_PRO); ++rep) { p0_prologue(a, lds, gw, NGW, wave, LANE()); __syncthreads(); }
    SEAM(PH_PRO);
    if (IN(PH_PROJ)) for (int rep = 0; rep < NREP(PH_PROJ); ++rep) {
        { pg8::Gemm g{1024, 1024, 1024}; SchedStd S; S.init(H1, 1024, ws + WS_WIN, 1024, MTOK, INC, G, bx); pg8::EpiProj E{PROJ, QKVH, 0.125f * LOG2E};
          pg8::gemm_phase<pg8::EpiProj, SchedStd, true, true>(lds, g, S, E); }
    }
    SEAM(PH_PROJ);
    if (IN(PH_ATTN)) for (int rep = 0; rep < NREP(PH_ATTN); ++rep) {
        { pg8::Gemm g{1024, 1024, 1024}; SchedStd S; S.init(ws + WS_MEMN, 1024, ws + WS_WKV, 1024, MMEM, 2048, G, bx); pg8::EpiStore E{KV, 2048, 0, 1.0f};
          pg8::gemm_phase<pg8::EpiStore, SchedStd, true, true>(lds, g, S, E); }
        { int t_ = threadIdx.x; asm volatile("" : "+v"(t_)); p2a_attn(QKVH, OP01, OP2, LSE, lds, G, bx, wave, t_); }
    }
    SEAM(PH_ATTN);
    if (IN(PH_MERGE)) for (int rep = 0; rep < NREP(PH_MERGE); ++rep) {
        int k256 = 256; asm volatile("" : "+s"(k256));
        { pg8::Gemm g{k256, 2048, 1024}; SchedMt S{G, bx, (const char*)KV, (const char*)(ws + WS_WQS)}; pg8::EpiStore E{MT, 1024, 0, 1.0f};
          pg8::gemm_phase<pg8::EpiStore, SchedMt, true, true>(lds, g, S, E); }
        { pg8::Gemm g{k256, 1024, 2048}; SchedNt S{G, bx, (const char*)KV, (const char*)(ws + WS_WO)}; pg8::EpiStore E{NT, 1024, 0, 1.0f};
          pg8::gemm_phase<pg8::EpiStore, SchedNt, true, true>(lds, g, S, E); }
        p3_merge(PROJ, OP01, OP2, LSE, a.in[I_CONVW], a.in[I_GATT], a.in[I_GCONV], MRG, gw, NGW, LANE());
    }
    SEAM(PH_MERGE);
    if (IN(PH_WOUT)) for (int rep = 0; rep < NREP(PH_WOUT); ++rep) { pg8::Gemm g{1024, 1024, 1024}; SchedStd S; S.init(MRG, 1024, ws + WS_WOUT, 1024, MTOK, 1024, G, bx); pg8::EpiResid<false> E{a.in[I_X], nullptr, H1, SS1};
        pg8::gemm_phase<pg8::EpiResid<false>, SchedStd, false, true>(lds, g, S, E); }
    SEAM(PH_WOUT);
    if (IN(PH_S)) for (int rep = 0; rep < NREP(PH_S); ++rep) { pg8::Gemm g{1024, 1024, 1024}; SchedStd S; S.init(H1, 1024, MT, 1024, MTOK, 1024, G, bx, 4, (size_t)1024 * 1024 * 2); pg8::EpiSoftmax E{SS1, PROJ, (LAS float*)(lds + XCH_OFF)};
        pg8::gemm_phase<pg8::EpiSoftmax, SchedStd, true, true>(lds, g, S, E); }
    SEAM(PH_S);
    if (IN(PH_PN)) for (int rep = 0; rep < NREP(PH_PN); ++rep) { pg8::Gemm g{1024, 1024, 1024}; SchedStd S; S.init(PROJ, 1024, NT, 1024, MTOK, 1024, G, bx, 4, (size_t)1024 * 1024 * 2); pg8::EpiResid<true> E{H1, nullptr, MRG, SS2};
        pg8::gemm_phase<pg8::EpiResid<true>, SchedStd, true, true>(lds, g, S, E); }
    SEAM(PH_PN);
    if (IN(PH_UP)) for (int rep = 0; rep < NREP(PH_UP); ++rep) { pg8::Gemm g{1024, 1024, 1024}; SchedStd S; S.init(MRG, 1024, ws + WS_WUP, 1024, MTOK, FF, G, bx); pg8::EpiRelu2 E{SS2, HID, HIDP};
        pg8::gemm_phase<pg8::EpiRelu2, SchedStd, true, true>(lds, g, S, E); }
    SEAM(PH_UP);
    const bool fuse_final = (G == 256) && IN(PH_DOWN) && IN(PH_FINAL);
    if (IN(PH_DOWN)) for (int rep = 0; rep < NREP(PH_DOWN); ++rep) { pg8::Gemm g{4096, HIDP, 4096}; SchedStd S; S.init(HID, HIDP, ws + WS_WDN, 4096, MTOK, 1024, G, bx);
        if (fuse_final) { pg8::EpiFinal E{MRG, a.out, a.in[I_GFIN], (unsigned*)(ws + WS_SS1), (unsigned*)ws + CW_PANEL, (LAS float*)(lds + XCH_OFF)};
            pg8::gemm_phase<pg8::EpiFinal, SchedStd, true, true>(lds, g, S, E); }
        else { pg8::EpiResid<true> E{MRG, a.out, nullptr, nullptr};
            pg8::gemm_phase<pg8::EpiResid<true>, SchedStd, true, true>(lds, g, S, E); } }
    if (!fuse_final) {
        SEAM(PH_DOWN);
        if (IN(PH_FINAL)) p8_final(a.out, a.in[I_GFIN], gw, NGW, LANE());
    }
#undef IN
#undef SEAM
}

extern "C" void kernel_launch(void* const* d_in, const int* in_sizes, int n_in, void* d_out, int out_size, void* d_ws, size_t ws_size, hipStream_t stream) {
    static int grid = 0;
    if (grid == 0) {
        if (n_in != 17 || in_sizes[0] != MTOK * DM || out_size != MTOK * DM || ws_size < WS_END) { fprintf(stderr, "kernel_launch: unexpected shapes (n_in %d, in0 %d, out %d, ws %zu); nothing launched\n", n_in, n_in > 0 ? in_sizes[0] : -1, out_size, ws_size); grid = -1; return; }
        int dev = 0, cus = 0, per_cu = 0;
        if (hipGetDevice(&dev) != hipSuccess || hipDeviceGetAttribute(&cus, hipDeviceAttributeMultiprocessorCount, dev) != hipSuccess) { grid = -1; return; }
        if (hipFuncSetAttribute((const void*)mega, hipFuncAttributeMaxDynamicSharedMemorySize, LDS_BYTES) != hipSuccess) { fprintf(stderr, "kernel_launch: hipFuncSetAttribute failed\n"); grid = -1; return; }
        if (hipOccupancyMaxActiveBlocksPerMultiprocessor(&per_cu, (const void*)mega, NWAVES * 64, LDS_BYTES) != hipSuccess || per_cu < 1) { fprintf(stderr, "kernel_launch: occupancy query says %d\n", per_cu); per_cu = 1; }
        (void)hipGetLastError();
        grid = cus * per_cu;
    }
    if (grid < 0) return;
    Args a{};
    for (int i = 0; i < 17; ++i) a.in[i] = (const float*)d_in[i];
    a.out = (float*)d_out; a.ws = (unsigned char*)d_ws;
#if N_LAUNCHES == 1
    if (hipMemsetAsync(d_ws, 0, 65536, stream) != hipSuccess) { fprintf(stderr, "kernel_launch: hipMemsetAsync failed\n"); return; }
    a.ph_lo = 0; a.ph_hi = NPHASE;
    void* args[] = {&a};
    hipError_t e = hipLaunchCooperativeKernel((const void*)mega, dim3(grid), dim3(NWAVES * 64), args, LDS_BYTES, stream);
    if (e != hipSuccess) fprintf(stderr, "kernel_launch: cooperative launch failed: %s (grid %d)\n", hipGetErrorString(e), grid);
#else
    for (int li = 0; li < NPHASE; ++li) { a.ph_lo = li; a.ph_hi = li + 1; hipLaunchKernelGGL(mega, dim3(grid), dim3(NWAVES * 64), LDS_BYTES, stream, a); }
#endif
}
```

```cpp
#include <hip/hip_runtime.h>
#include <hip/hip_cooperative_groups.h>
#include <cstdio>
#include <cstdint>
namespace cg = cooperative_groups;

#ifndef N_LAUNCHES
#define N_LAUNCHES 1
#endif

namespace pg8 {
#define PG8_LAS __attribute__((address_space(3)))
typedef unsigned short bf16_t;
typedef short bf16x8 __attribute__((ext_vector_type(8)));
typedef float f32x4 __attribute__((ext_vector_type(4)));
typedef unsigned u32x4 __attribute__((ext_vector_type(4)));
constexpr int BM = 256, BK = 64, HALF = 128, HTB = HALF * BK * 2  , STAGE_BYTES = 8 * HTB, NXCD = 8, WGM = 8;

__host__ __device__ __forceinline__ int lds_byte(int r, int c) { const int st = (r >> 4) * 2 + (c >> 5), rr = r & 15, cc = c & 31, ob = rr * 64 + cc * 2; return st * 1024 + (ob ^ (((ob >> 9) & 1) << 5)); }
__host__ __device__ __forceinline__ void stage_rc(int b, int& R, int& C) { const int st = b / 1024, sb = b % 1024, swz = sb ^ (((sb >> 9) & 1) << 5); R = (st >> 1) * 16 + swz / 64; C = (st & 1) * 32 + (swz % 64) / 2; }
__host__ __device__ __forceinline__ int perm32(int rho) { const int n = rho >> 4, i = rho & 15; return 8 * (i >> 2) + 4 * n + (i & 3); }

struct Unit { int pm, pn; const char* a; const char* b; };
struct Gemm { int K, lda, ldb; };

struct StaticOrder {
    int nM, nN, nwg, G, c;
    __host__ __device__ void init(int M, int N, int G_, int c_) { nM = M / BM; nN = N / BM; nwg = nM * nN; G = G_; c = c_; }
    __host__ __device__ bool next(int i, Unit& u) const {
        const long L = (long)i * G + c; if (L >= nwg) return false;
        int wgid = (int)L; { const int q = nwg / NXCD, r = nwg % NXCD, xcd = wgid % NXCD, off = wgid / NXCD; wgid = (xcd < r ? xcd * (q + 1) : r * (q + 1) + (xcd - r) * q) + off; }
        const int nig = WGM * nN, gid = wgid / nig, fm = gid * WGM, gsz = (nM - fm) < WGM ? (nM - fm) : WGM;
        u.pm = fm + ((wgid % nig) % gsz); u.pn = (wgid % nig) / gsz; return true;
    }
};
__device__ __forceinline__ unsigned cvt_pk_bf16(float lo, float hi) { unsigned r; asm volatile("v_cvt_pk_bf16_f32 %0, %1, %2" : "=v"(r) : "v"(lo), "v"(hi)); return r; }

__device__ __forceinline__ u32x4 pack8(f32x4 v0, f32x4 v1) { u32x4 w; w.x = cvt_pk_bf16(v0[0], v0[1]); w.y = cvt_pk_bf16(v0[2], v0[3]); w.z = cvt_pk_bf16(v1[0], v1[1]); w.w = cvt_pk_bf16(v1[2], v1[3]); return w; }
__device__ __forceinline__ float sum16(const float* sp) { const f32x4 a = *(const f32x4*)sp, b = *(const f32x4*)(sp + 4), c = *(const f32x4*)(sp + 8), d = *(const f32x4*)(sp + 12);
    return ((a[0] + a[1]) + (a[2] + a[3])) + ((b[0] + b[1]) + (b[2] + b[3])) + ((c[0] + c[1]) + (c[2] + c[3])) + ((d[0] + d[1]) + (d[2] + d[3])); }

#define WT_RSRC(p) __builtin_amdgcn_make_buffer_rsrc((void*)(p), 0, 0x7ffffff0, 0x00020000)
__device__ __forceinline__ void st16wt(__amdgpu_buffer_rsrc_t r, size_t elem_off, u32x4 w) { __builtin_amdgcn_raw_buffer_store_b128(w, r, (unsigned)(elem_off * 2), 0,   16); }
__device__ __forceinline__ void row_scales(const float* SS, int row0, int fq, float (&rs)[2][4]) {
    f32x4 t[2][4];
#pragma unroll
    for (int ai = 0; ai < 2; ++ai)
#pragma unroll
        for (int m = 0; m < 4; ++m) t[ai][m] = *(const f32x4*)(SS + (size_t)(row0 + ai * HALF + m * 16) * 16 + fq * 4);
#pragma unroll
    for (int ai = 0; ai < 2; ++ai)
#pragma unroll
        for (int m = 0; m < 4; ++m) { float s = (t[ai][m][0] + t[ai][m][1]) + (t[ai][m][2] + t[ai][m][3]); s += __shfl_xor(s, 16); s += __shfl_xor(s, 32); rs[ai][m] = __builtin_amdgcn_rsqf(s * (1.0f / 1024.0f) + 1e-6f); }
}
struct EpiStore {
    static constexpr bool PERM = true, AFTER_DRAIN = false;
    bf16_t* O; int ldc; int npn_scaled; float scale0;
    __device__ __forceinline__ void operator()(f32x4 (&acc)[2][2][4][2], const Unit& u, int wr, int wc, int fr, int fq) const {
        const int row0 = u.pm * BM + wr * 64 + fr, col0 = u.pn * BM + wc * 32 + 8 * fq;
        const float sc = (u.pn < npn_scaled) ? scale0 : 1.0f;
        const __amdgpu_buffer_rsrc_t ors = WT_RSRC(O);
#pragma unroll
        for (int ai = 0; ai < 2; ++ai)
#pragma unroll
            for (int m = 0; m < 4; ++m) { const size_t ro = (size_t)(row0 + ai * HALF + m * 16) * ldc + col0;
#pragma unroll
                for (int bj = 0; bj < 2; ++bj) st16wt(ors, ro + bj * HALF, pack8(acc[ai][bj][m][0] * sc, acc[ai][bj][m][1] * sc)); }
    }
};
struct EpiProj {
    static constexpr bool PERM = true, AFTER_DRAIN = false;
    bf16_t* PC; bf16_t* QKV; float scale0;
    __device__ __forceinline__ void operator()(f32x4 (&acc)[2][2][4][2], const Unit& u, int wr, int wc, int fr, int fq) const {
        const int row0 = u.pm * BM + wr * 64 + fr;
        const __amdgpu_buffer_rsrc_t prs = WT_RSRC(PC), qrs = WT_RSRC(QKV);
        if (u.pn >= 6) {
            const int col0 = (u.pn - 6) * BM + wc * 32 + 8 * fq;
#pragma unroll
            for (int ai = 0; ai < 2; ++ai)
#pragma unroll
                for (int m = 0; m < 4; ++m) { const size_t ro = (size_t)(row0 + ai * HALF + m * 16) * 1536 + col0;
#pragma unroll
                    for (int bj = 0; bj < 2; ++bj) __builtin_amdgcn_raw_buffer_store_b128(pack8(acc[ai][bj][m][0], acc[ai][bj][m][1]), prs, (unsigned)((ro + bj * HALF) * 2), 0, 18); }
        } else {
            const float sc = (u.pn < 2) ? scale0 : 1.0f;
            const int which = u.pn >> 1, d = (wc & 1) * 32 + 8 * fq;
            const size_t base = (size_t)which * 32768 * 512 + d;
#pragma unroll
            for (int ai = 0; ai < 2; ++ai)
#pragma unroll
                for (int m = 0; m < 4; ++m) { const int row = row0 + ai * HALF + m * 16;
#pragma unroll
                    for (int bj = 0; bj < 2; ++bj) { const int h = 4 * (u.pn & 1) + 2 * bj + (wc >> 1);
                        st16wt(qrs, base + ((size_t)((row >> 12) * 8 + h) * 4096 + (row & 4095)) * 64, pack8(acc[ai][bj][m][0] * sc, acc[ai][bj][m][1] * sc)); } }
        }
    }
};
template <bool BASE_BF16> struct EpiResid {
    static constexpr bool PERM = true, AFTER_DRAIN = false;
    const void* base; float* out; bf16_t* xb; float* SS;
    __device__ __forceinline__ void operator()(f32x4 (&acc)[2][2][4][2], const Unit& u, int wr, int wc, int fr, int fq) const {
        const int row0 = u.pm * BM + wr * 64 + fr, col0 = u.pn * BM + wc * 32 + 8 * fq;
        const __amdgpu_buffer_rsrc_t xrs = WT_RSRC(xb);
#pragma unroll
        for (int ai = 0; ai < 2; ++ai) {
            u32x4 wb[4][2]; f32x4 fb[4][2][2];
#pragma unroll
            for (int m = 0; m < 4; ++m)
#pragma unroll
                for (int bj = 0; bj < 2; ++bj) { const size_t off = (size_t)(row0 + ai * HALF + m * 16) * 1024 + col0 + bj * HALF;
                    if (BASE_BF16) wb[m][bj] = *(const u32x4*)((const bf16_t*)base + off);
                    else { fb[m][bj][0] = *(const f32x4*)((const float*)base + off); fb[m][bj][1] = *(const f32x4*)((const float*)base + off + 4); } }
#pragma unroll
            for (int m = 0; m < 4; ++m) { const int row = row0 + ai * HALF + m * 16; float ss = 0.f;
#pragma unroll
                for (int bj = 0; bj < 2; ++bj) { const size_t off = (size_t)row * 1024 + col0 + bj * HALF;
                    f32x4 b0, b1;
                    if (BASE_BF16) { const u32x4 w = wb[m][bj];
                        b0 = (f32x4){__uint_as_float(w.x << 16), __uint_as_float(w.x & 0xffff0000u), __uint_as_float(w.y << 16), __uint_as_float(w.y & 0xffff0000u)};
                        b1 = (f32x4){__uint_as_float(w.z << 16), __uint_as_float(w.z & 0xffff0000u), __uint_as_float(w.w << 16), __uint_as_float(w.w & 0xffff0000u)}; }
                    else { b0 = fb[m][bj][0]; b1 = fb[m][bj][1]; }
                    const f32x4 v0 = acc[ai][bj][m][0] + b0, v1 = acc[ai][bj][m][1] + b1;
                    if (out) { *(f32x4*)(out + off) = v0; *(f32x4*)(out + off + 4) = v1; }
                    if (xb) st16wt(xrs, off, pack8(v0, v1));
                    ss += ((v0[0] * v0[0] + v0[1] * v0[1]) + (v0[2] * v0[2] + v0[3] * v0[3])) + ((v1[0] * v1[0] + v1[1] * v1[1]) + (v1[2] * v1[2] + v1[3] * v1[3])); }
                if (SS) { ss += __shfl_xor(ss, 16); ss += __shfl_xor(ss, 32); if (fq == 0) SS[(size_t)row * 16 + u.pn * 4 + wc] = ss; } }
            asm volatile("" ::: "memory");
        }
    }
};
struct EpiRelu2 {
    static constexpr bool PERM = true, AFTER_DRAIN = false;
    const float* SS; bf16_t* O; int ldo;
    __device__ __forceinline__ void operator()(f32x4 (&acc)[2][2][4][2], const Unit& u, int wr, int wc, int fr, int fq) const {
        const int row0 = u.pm * BM + wr * 64 + fr, col0 = u.pn * BM + wc * 32 + 8 * fq;
        const __amdgpu_buffer_rsrc_t hrs = WT_RSRC(O);
        float rsv[2][4]; row_scales(SS, row0, fq, rsv);
#pragma unroll
        for (int ai = 0; ai < 2; ++ai)
#pragma unroll
            for (int m = 0; m < 4; ++m) { const int row = row0 + ai * HALF + m * 16;
                const float rs = rsv[ai][m];
                bf16_t* rowp = O + (size_t)row * ldo + col0;
#pragma unroll
                for (int bj = 0; bj < 2; ++bj) { f32x4 v0 = acc[ai][bj][m][0] * rs, v1 = acc[ai][bj][m][1] * rs;
#pragma unroll
                    for (int e = 0; e < 4; ++e) { const float a = fmaxf(v0[e], 0.f), b = fmaxf(v1[e], 0.f); v0[e] = a * a; v1[e] = b * b; }
                    __builtin_amdgcn_raw_buffer_store_b128(pack8(v0, v1), hrs, (unsigned)(((size_t)row * ldo + col0 + bj * HALF) * 2), 0, 18); } }
    }
};
struct EpiSoftmax {
    static constexpr bool PERM = true, AFTER_DRAIN = false;
    const float* SS; bf16_t* P; PG8_LAS float* xch;
    __device__ __forceinline__ void operator()(f32x4 (&acc)[2][2][4][2], const Unit& u, int wr, int wc, int fr, int fq) const {
        const int row0 = u.pm * BM + wr * 64 + fr, col0 = u.pn * BM + wc * 32 + 8 * fq;
        const __amdgpu_buffer_rsrc_t prs = WT_RSRC(P);
        float mw[2][4];
        float rsv[2][4]; row_scales(SS, row0, fq, rsv);
#pragma unroll
        for (int ai = 0; ai < 2; ++ai)
#pragma unroll
            for (int m = 0; m < 4; ++m) { const int rl = ai * HALF + wr * 64 + m * 16 + fr;
                const float sc = rsv[ai][m] * (0.0625f * 1.4426950408889634f);
                float mx = -3.0e38f;
#pragma unroll
                for (int bj = 0; bj < 2; ++bj)
#pragma unroll
                    for (int n = 0; n < 2; ++n) { f32x4 v = acc[ai][bj][m][n] * sc; acc[ai][bj][m][n] = v; mx = fmaxf(mx, fmaxf(fmaxf(v[0], v[1]), fmaxf(v[2], v[3]))); }
                mx = fmaxf(mx, __shfl_xor(mx, 16)); mx = fmaxf(mx, __shfl_xor(mx, 32));
                float l = 0.f;
#pragma unroll
                for (int bj = 0; bj < 2; ++bj)
#pragma unroll
                    for (int n = 0; n < 2; ++n) { f32x4 v = acc[ai][bj][m][n];
#pragma unroll
                        for (int e = 0; e < 4; ++e) { v[e] = __builtin_amdgcn_exp2f(v[e] - mx); l += v[e]; }
                        acc[ai][bj][m][n] = v; }
                l += __shfl_xor(l, 16); l += __shfl_xor(l, 32);
                mw[ai][m] = mx;
                if (fq == 0) { xch[rl * 8 + wc * 2] = mx; xch[rl * 8 + wc * 2 + 1] = l; } }
        asm volatile("s_waitcnt lgkmcnt(0)\n\ts_barrier" ::: "memory");
#pragma unroll
        for (int ai = 0; ai < 2; ++ai)
#pragma unroll
            for (int m = 0; m < 4; ++m) { const int row = row0 + ai * HALF + m * 16; const int rl = ai * HALF + wr * 64 + m * 16 + fr;
                const f32x4 x0 = *(const PG8_LAS f32x4*)(xch + rl * 8), x1 = *(const PG8_LAS f32x4*)(xch + rl * 8 + 4);
                const float M = fmaxf(fmaxf(x0[0], x0[2]), fmaxf(x1[0], x1[2]));
                const float L = (x0[1] * __builtin_amdgcn_exp2f(x0[0] - M) + x0[3] * __builtin_amdgcn_exp2f(x0[2] - M)) + (x1[1] * __builtin_amdgcn_exp2f(x1[0] - M) + x1[3] * __builtin_amdgcn_exp2f(x1[2] - M));
                const float fac = __builtin_amdgcn_exp2f(mw[ai][m] - M) * __builtin_amdgcn_rcpf(L);
                bf16_t* rowp = P + (size_t)row * 1024 + col0;
#pragma unroll
                for (int bj = 0; bj < 2; ++bj) st16wt(prs, (size_t)row * 1024 + col0 + bj * HALF, pack8(acc[ai][bj][m][0] * fac, acc[ai][bj][m][1] * fac)); }
        asm volatile("s_waitcnt lgkmcnt(0)" ::: "memory");
    }
};

struct EpiFinal {
    static constexpr bool PERM = true, AFTER_DRAIN = false;
    const bf16_t* base; float* out; const float* gain; unsigned* slots; unsigned* cnt; PG8_LAS float* tab;
    __device__ __forceinline__ void operator()(f32x4 (&acc)[2][2][4][2], const Unit& u, int wr, int wc, int fr, int fq) const {
        const int row0 = u.pm * BM + wr * 64 + fr, col0 = u.pn * BM + wc * 32 + 8 * fq;
        const int lane = fr + 16 * fq, wid = wr * 4 + wc;
        PG8_LAS float* Ptab = tab; PG8_LAS float* Stab = tab + 1024;
#pragma unroll
        for (int ai = 0; ai < 2; ++ai)
#pragma unroll
            for (int m = 0; m < 4; ++m) { const int row = row0 + ai * HALF + m * 16; float ss = 0.f;
#pragma unroll
                for (int bj = 0; bj < 2; ++bj) { const size_t off = (size_t)row * 1024 + col0 + bj * HALF;
                    const u32x4 w = *(const u32x4*)(base + off);
                    const f32x4 b0 = (f32x4){__uint_as_float(w.x << 16), __uint_as_float(w.x & 0xffff0000u), __uint_as_float(w.y << 16), __uint_as_float(w.y & 0xffff0000u)};
                    const f32x4 b1 = (f32x4){__uint_as_float(w.z << 16), __uint_as_float(w.z & 0xffff0000u), __uint_as_float(w.w << 16), __uint_as_float(w.w & 0xffff0000u)};
                    const f32x4 v0 = acc[ai][bj][m][0] + b0, v1 = acc[ai][bj][m][1] + b1; acc[ai][bj][m][0] = v0; acc[ai][bj][m][1] = v1;
                    ss += ((v0[0] * v0[0] + v0[1] * v0[1]) + (v0[2] * v0[2] + v0[3] * v0[3])) + ((v1[0] * v1[0] + v1[1] * v1[1]) + (v1[2] * v1[2] + v1[3] * v1[3])); }
                ss += __shfl_xor(ss, 16); ss += __shfl_xor(ss, 32);
                if (fq == 0) Ptab[(ai * HALF + wr * 64 + m * 16 + fr) * 4 + wc] = ss; }
        asm volatile("s_waitcnt lgkmcnt(0)\n\ts_barrier" ::: "memory");
        const int rowl = wid * 32 + (lane & 31);
        if (lane < 32) { const f32x4 p = *(const PG8_LAS f32x4*)(Ptab + rowl * 4);
            __hip_atomic_store(slots + ((size_t)(u.pm * BM + rowl) * 4 + u.pn), __float_as_uint((p[0] + p[1]) + (p[2] + p[3])), __ATOMIC_RELAXED, __HIP_MEMORY_SCOPE_AGENT); }
        asm volatile("s_waitcnt vmcnt(0)" ::: "memory");
        if (lane == 0) __hip_atomic_fetch_add(cnt + 64 * u.pm, 1u, __ATOMIC_RELAXED, __HIP_MEMORY_SCOPE_AGENT);
        if (wid == 0) {
            unsigned sp = 0;
            while ((unsigned)__builtin_amdgcn_readfirstlane(__hip_atomic_load(cnt + 64 * u.pm, __ATOMIC_RELAXED, __HIP_MEMORY_SCOPE_AGENT)) < 32u) { __builtin_amdgcn_s_sleep(2); if (++sp > (1u << 22)) break; }
            __builtin_amdgcn_fence(__ATOMIC_ACQUIRE, "agent");
        }
        asm volatile("s_waitcnt vmcnt(0) lgkmcnt(0)\n\ts_barrier" ::: "memory");
        if (lane < 32) { const unsigned* sl = slots + (size_t)(u.pm * BM + rowl) * 4; float t = 0.f;
#pragma unroll
            for (int k = 0; k < 4; ++k) t += __uint_as_float(__hip_atomic_load(sl + k, __ATOMIC_RELAXED, __HIP_MEMORY_SCOPE_AGENT));
            Stab[rowl] = 1.0f / sqrtf(t * (1.0f / 1024.0f) + 1e-6f); }
        asm volatile("s_waitcnt vmcnt(0) lgkmcnt(0)\n\ts_barrier" ::: "memory");
        f32x4 g[2][2];
#pragma unroll
        for (int bj = 0; bj < 2; ++bj) { g[bj][0] = *(const f32x4*)(gain + col0 + bj * HALF); g[bj][1] = *(const f32x4*)(gain + col0 + bj * HALF + 4); }
#pragma unroll
        for (int ai = 0; ai < 2; ++ai)
#pragma unroll
            for (int m = 0; m < 4; ++m) { const int row = row0 + ai * HALF + m * 16; const float rs = Stab[ai * HALF + wr * 64 + m * 16 + fr];
#pragma unroll
                for (int bj = 0; bj < 2; ++bj) { const size_t off = (size_t)row * 1024 + col0 + bj * HALF;
                    *(f32x4*)(out + off) = acc[ai][bj][m][0] * rs * g[bj][0]; *(f32x4*)(out + off + 4) = acc[ai][bj][m][1] * rs * g[bj][1]; } }
        asm volatile("s_waitcnt lgkmcnt(0)" ::: "memory");
    }
};

template <class Epi, class Sched, bool ALIGN_EPI = false, bool SP2 = false>
__device__ __forceinline__ void gemm_phase(PG8_LAS unsigned char* lds, const Gemm g, const Sched& S, const Epi& E) {
    int tid = threadIdx.x; asm volatile("" : "+v"(tid));
    const int wid = __builtin_amdgcn_readfirstlane(tid >> 6), lane = tid & 63, wr = wid >> 2, wc = wid & 3, fr = lane & 15, fq = lane >> 4;
    const int K = g.K, nt = K / BK;
    unsigned voffA[2], voffB[2];
#pragma unroll
    for (int i = 0; i < 2; ++i) { int R, C; stage_rc(tid * 16 + i * 8192, R, C); const int Rb = Epi::PERM ? ((R & ~31) + perm32(R & 31)) : R;
        voffA[i] = (unsigned)(R * g.lda + C) * 2u; voffB[i] = (unsigned)(Rb * g.ldb + C) * 2u; }
    const size_t kstep = (size_t)(BK * 2);
    const size_t hstepA = (size_t)HALF * g.lda * 2, hstepB = (size_t)HALF * g.ldb * 2;
        const unsigned ldsw = (unsigned)wid * 1024u;
    const int aoff = lds_byte(wr * 64 + fr, fq * 8), boff = lds_byte(wc * 32 + fr, fq * 8);
#define PG8_SA(b, h) (((b) * 2 + (h)) * HTB)
#define PG8_SB(b, h) ((4 + (b) * 2 + (h)) * HTB)
#define PG8_STAGE(bufoff, gbase, voff) do { _Pragma("unroll") for (int _i = 0; _i < 2; ++_i) \
        __builtin_amdgcn_global_load_lds((const unsigned*)((const char*)(gbase) + (voff)[_i]), (PG8_LAS unsigned*)(lds + (bufoff) + ldsw + _i * 8192), 16, 0, 0); } while (0)
#define PG8_LDA(dst, b, h) do { _Pragma("unroll") for (int m = 0; m < 4; ++m) _Pragma("unroll") for (int k = 0; k < 2; ++k) dst[m][k] = *(const PG8_LAS bf16x8*)(lds + PG8_SA(b, h) + aoff + m * 2048 + k * 1024); } while (0)
#define PG8_LDB(dst, b, h) do { _Pragma("unroll") for (int n = 0; n < 2; ++n) _Pragma("unroll") for (int k = 0; k < 2; ++k) dst[n][k] = *(const PG8_LAS bf16x8*)(lds + PG8_SB(b, h) + boff + n * 2048 + k * 1024); } while (0)
#define PG8_MMA(ai, bj, At, Bt) do { __builtin_amdgcn_s_setprio(1); _Pragma("unroll") for (int m = 0; m < 4; ++m) _Pragma("unroll") for (int n = 0; n < 2; ++n) _Pragma("unroll") for (int k = 0; k < 2; ++k) \
        acc[ai][bj][m][n] = __builtin_amdgcn_mfma_f32_16x16x32_bf16(Bt[n][k], At[m][k], acc[ai][bj][m][n], 0, 0, 0); __builtin_amdgcn_s_setprio(0); } while (0)
#define PG8_WAIT_V(n) asm volatile("s_waitcnt vmcnt(" #n ")" ::: "memory")
#define PG8_WAIT_L(n) asm volatile("s_waitcnt lgkmcnt(" #n ")" ::: "memory")
#define PG8_BAR __builtin_amdgcn_s_barrier()
#define PG8_SCHED __builtin_amdgcn_sched_barrier(0)
    Unit cur, nxt; int ui = 0;
    if (!S.next(0, cur)) return;
    f32x4 acc[2][2][4][2];
#pragma unroll
    for (int a = 0; a < 2; ++a)
#pragma unroll
        for (int b = 0; b < 2; ++b)
#pragma unroll
            for (int m = 0; m < 4; ++m)
#pragma unroll
                for (int n = 0; n < 2; ++n) acc[a][b][m][n] = (f32x4){0.f, 0.f, 0.f, 0.f};
    bf16x8 At[4][2], B0[2][2], B1[2][2];
    const char* cA = cur.a; const char* cB = cur.b;
    S.a_ready(cur);
    if constexpr (SP2) {
        PG8_STAGE(PG8_SB(0, 0), cB, voffB); PG8_STAGE(PG8_SB(0, 1), cB + hstepB, voffB); PG8_STAGE(PG8_SA(0, 0), cA, voffA); PG8_STAGE(PG8_SA(0, 1), cA + hstepA, voffA);
        if (wr == 1) PG8_BAR;
        PG8_WAIT_V(2); PG8_BAR;
        PG8_STAGE(PG8_SB(1, 0), cB + kstep, voffB); PG8_STAGE(PG8_SA(1, 0), cA + kstep, voffA); PG8_STAGE(PG8_SB(1, 1), cB + hstepB + kstep, voffB);
        PG8_WAIT_V(6); PG8_BAR;
    } else {
        PG8_STAGE(PG8_SB(0, 0), cB, voffB); PG8_STAGE(PG8_SA(0, 0), cA, voffA); PG8_STAGE(PG8_SB(0, 1), cB + hstepB, voffB); PG8_STAGE(PG8_SA(0, 1), cA + hstepA, voffA);
        if (wr == 1) PG8_BAR;
        PG8_WAIT_V(4); PG8_BAR;
        PG8_STAGE(PG8_SB(1, 0), cB + kstep, voffB); PG8_STAGE(PG8_SA(1, 0), cA + kstep, voffA); PG8_STAGE(PG8_SB(1, 1), cB + hstepB + kstep, voffB);
        PG8_WAIT_V(6); PG8_BAR;
    }
    for (;;) {
        const bool has_next = S.next(ui + 1, nxt);
        const char* nA = has_next ? nxt.a : cA; const char* nB = has_next ? nxt.b : cB;
        for (int t = 0; t < nt; t += 2) {
            const bool last = (t == nt - 2);
            const char* a1 = cA + (size_t)(t + 1) * kstep;
            const char* a2 = last ? nA : cA + (size_t)(t + 2) * kstep; const char* b2 = last ? nB : cB + (size_t)(t + 2) * kstep;
            const char* a3 = a2 + kstep; const char* b3 = b2 + kstep;
            if (last && has_next) S.a_ready(nxt);
            if constexpr (SP2) {
            PG8_LDB(B0, 0, 0); PG8_LDB(B1, 0, 1); PG8_SCHED; PG8_LDA(At, 0, 0); PG8_STAGE(PG8_SA(1, 1), a1 + hstepA, voffA);
            PG8_WAIT_V(8); PG8_WAIT_L(0); PG8_BAR; PG8_MMA(0, 0, At, B0); PG8_MMA(0, 1, At, B1); PG8_BAR; PG8_SCHED;
            PG8_LDA(At, 0, 1); PG8_STAGE(PG8_SB(0, 0), b2, voffB); PG8_STAGE(PG8_SB(0, 1), b2 + hstepB, voffB); PG8_STAGE(PG8_SA(0, 0), a2, voffA);
            PG8_WAIT_V(8); PG8_WAIT_L(0); PG8_BAR; PG8_MMA(1, 0, At, B0); PG8_MMA(1, 1, At, B1); PG8_BAR; PG8_SCHED;
            PG8_LDB(B0, 1, 0); PG8_LDB(B1, 1, 1); PG8_SCHED; PG8_LDA(At, 1, 0); PG8_STAGE(PG8_SA(0, 1), a2 + hstepA, voffA);
            PG8_WAIT_V(8); PG8_WAIT_L(0); PG8_BAR; PG8_MMA(0, 0, At, B0); PG8_MMA(0, 1, At, B1); PG8_BAR; PG8_SCHED;
            PG8_LDA(At, 1, 1); PG8_STAGE(PG8_SB(1, 0), b3, voffB); PG8_STAGE(PG8_SB(1, 1), b3 + hstepB, voffB); PG8_STAGE(PG8_SA(1, 0), a3, voffA);
            PG8_WAIT_V(8); PG8_WAIT_L(0); PG8_BAR; PG8_MMA(1, 0, At, B0); PG8_MMA(1, 1, At, B1); PG8_BAR; PG8_SCHED;
            } else {
            PG8_LDB(B0, 0, 0); PG8_SCHED; PG8_LDA(At, 0, 0); PG8_STAGE(PG8_SA(1, 1), a1 + hstepA, voffA);
            PG8_WAIT_L(8); PG8_BAR; PG8_WAIT_L(0); PG8_MMA(0, 0, At, B0); PG8_BAR; PG8_SCHED;
            PG8_LDB(B1, 0, 1); PG8_STAGE(PG8_SB(0, 0), b2, voffB);
            PG8_BAR; PG8_WAIT_L(0); PG8_MMA(0, 1, At, B1); PG8_BAR;
            PG8_LDA(At, 0, 1); PG8_STAGE(PG8_SA(0, 0), a2, voffA);
            PG8_BAR; PG8_WAIT_L(0); PG8_MMA(1, 0, At, B0); PG8_BAR; PG8_SCHED;
            PG8_STAGE(PG8_SB(0, 1), b2 + hstepB, voffB);
            PG8_WAIT_V(6); PG8_BAR; PG8_MMA(1, 1, At, B1); PG8_BAR;
            PG8_LDB(B0, 1, 0); PG8_SCHED; PG8_LDA(At, 1, 0); PG8_STAGE(PG8_SA(0, 1), a2 + hstepA, voffA);
            PG8_WAIT_L(8); PG8_BAR; PG8_WAIT_L(0); PG8_MMA(0, 0, At, B0); PG8_BAR; PG8_SCHED;
            PG8_LDB(B1, 1, 1); PG8_STAGE(PG8_SB(1, 0), b3, voffB);
            PG8_BAR; PG8_WAIT_L(0); PG8_MMA(0, 1, At, B1); PG8_BAR;
            PG8_LDA(At, 1, 1); PG8_STAGE(PG8_SA(1, 0), a3, voffA);
            PG8_BAR; PG8_WAIT_L(0); PG8_MMA(1, 0, At, B0); PG8_BAR; PG8_SCHED;
            PG8_STAGE(PG8_SB(1, 1), b3 + hstepB, voffB);
            PG8_WAIT_V(6); PG8_BAR; PG8_MMA(1, 1, At, B1); PG8_BAR;
            }
        }
        if constexpr (ALIGN_EPI) { if (wr == 0) PG8_BAR; }
        if constexpr (!Epi::AFTER_DRAIN) { E(acc, cur, wr, wc, fr, fq); S.done(cur); }
        if (!has_next) break;
#pragma unroll
        for (int a = 0; a < 2; ++a)
#pragma unroll
            for (int b = 0; b < 2; ++b)
#pragma unroll
                for (int m = 0; m < 4; ++m)
#pragma unroll
                    for (int n = 0; n < 2; ++n) acc[a][b][m][n] = (f32x4){0.f, 0.f, 0.f, 0.f};
        cur = nxt; cA = nA; cB = nB; ++ui;
        if constexpr (ALIGN_EPI) { if (wr == 1) PG8_BAR; }
    }
    PG8_WAIT_V(0);
    if constexpr (!ALIGN_EPI) { if (wr == 0) PG8_BAR; }
    PG8_BAR;
    if constexpr (Epi::AFTER_DRAIN) { E.fused(acc, cur, wr, wc, fr, fq, lds, wid, lane); S.done(cur); }
#undef PG8_SA
#undef PG8_SB
#undef PG8_STAGE
#undef PG8_LDA
#undef PG8_LDB
#undef PG8_MMA
#undef PG8_WAIT_V
#undef PG8_WAIT_L
#undef PG8_BAR
#undef PG8_SCHED
}}

struct SchedStd {
    pg8::StaticOrder so; const char* A; const char* B; size_t tA, tB, bstride; int bshift;
    __device__ __forceinline__ void init(const void* A_, int lda, const void* B_, int ldb, int M, int N, int G, int c, int bshift_ = 30, size_t bstride_ = 0) {
        so.init(M, N, G, c); A = (const char*)A_; B = (const char*)B_; tA = (size_t)256 * lda * 2; tB = (size_t)256 * ldb * 2; bshift = bshift_; bstride = bstride_; }
    __device__ __forceinline__ bool next(int i, pg8::Unit& u) const { if (!so.next(i, u)) return false; u.a = A + (size_t)u.pm * tA; u.b = B + (size_t)u.pn * tB + (size_t)(u.pm >> bshift) * bstride; return true; }
    __device__ __forceinline__ void a_ready(const pg8::Unit&) const {}
    __device__ __forceinline__ void done(const pg8::Unit&) const {}
};
struct SchedMt {
    int G, c; const char* KV; const char* WqS;
    __device__ __forceinline__ bool next(int i, pg8::Unit& u) const { const int L = i * G + c; if (L >= 128) return false; const int b = L >> 4, h = (L >> 2) & 3, pn = L & 3;
        u.pm = b * 4 + h; u.pn = pn; u.a = KV + ((size_t)(b * 256) * 2048 + h * 256) * 2; u.b = WqS + ((size_t)pn * 256 * 1024 + h * 256) * 2; return true; }
    __device__ __forceinline__ void a_ready(const pg8::Unit&) const {}
    __device__ __forceinline__ void done(const pg8::Unit&) const {}
};
struct SchedNt {
    int G, c; const char* KV; const char* WoT;
    __device__ __forceinline__ bool next(int i, pg8::Unit& u) const { const int L = i * G + ((c + G / 2) % G); if (L >= 128) return false; const int b = L >> 4, pmc = (L >> 2) & 3, h = L & 3;
        u.pm = b * 4 + pmc; u.pn = h; u.a = WoT + ((size_t)pmc * 256 * 1024 + h * 256) * 2; u.b = KV + ((size_t)(b * 256) * 2048 + 1024 + h * 256) * 2; return true; }
    __device__ __forceinline__ void a_ready(const pg8::Unit&) const {}
    __device__ __forceinline__ void done(const pg8::Unit&) const {}
};

constexpr int NB = 8, SEQ = 4096, DM = 1024, MTOK = NB * SEQ, MEMLEN = 256, MMEM = NB * MEMLEN, INC = 3072, FF = 4096, AW = 512;
constexpr float EPS = 1e-6f, LOG2E = 1.4426950408889634f;
constexpr int NWAVES = 8;
constexpr size_t MiB = 1u << 20;
constexpr size_t WS_WIN = 1 * MiB, WS_WOUT = 7 * MiB, WS_WQS = 9 * MiB, WS_WKV = 11 * MiB, WS_WO = 15 * MiB, WS_WUP = 17 * MiB, WS_WDN = 25 * MiB;
constexpr size_t WS_MEMN = 33 * MiB, WS_KV = 37 * MiB, WS_MT = 45 * MiB, WS_NT = 61 * MiB, WS_SS1 = 77 * MiB, WS_SS2 = 79 * MiB;
constexpr size_t WS_H1 = 96 * MiB;
constexpr size_t WS_PROJ = 160 * MiB;
constexpr size_t WS_QKV = 256 * MiB;
constexpr int CONVP = 1536;
constexpr int HIDP = 4096 + 64;
constexpr size_t WS_MRG = 358 * MiB;
constexpr size_t WS_HID = 96 * MiB;
constexpr size_t WS_LSE = 82 * MiB;
constexpr size_t WS_OP01 = 96 * MiB;
constexpr size_t WS_OP2 = 422 * MiB;
constexpr size_t WS_END = 454 * MiB;
static_assert(WS_HID + (size_t)MTOK * HIDP * 2 <= WS_MRG && WS_MRG + (size_t)MTOK * 1024 * 2 <= WS_OP2 && WS_OP2 + (size_t)MTOK * AW * 2 <= WS_END, "d_ws map");
constexpr int RING_BYTES = 131072, XCH_OFF = RING_BYTES, LDS_BYTES = RING_BYTES + 8192 + 4096;

#define LAS __attribute__((address_space(3)))
typedef unsigned short bf16;
typedef float f32x4 __attribute__((ext_vector_type(4)));
typedef unsigned u32x4 __attribute__((ext_vector_type(4)));
typedef unsigned u32x2 __attribute__((ext_vector_type(2)));
#define LDS_WAIT() asm volatile("s_waitcnt lgkmcnt(0)" ::: "memory")
__device__ __forceinline__ unsigned f2bf(float f) { unsigned u = __builtin_bit_cast(unsigned, f); return (u + 0x7fffu + ((u >> 16) & 1u)) >> 16; }
__device__ __forceinline__ unsigned pk2(float lo, float hi) { return f2bf(lo) | (f2bf(hi) << 16); }
__device__ __forceinline__ float bf2f(unsigned v) { return __uint_as_float(v << 16); }
__device__ __forceinline__ float wave_sum(float v) {
#pragma unroll
    for (int o = 1; o < 64; o <<= 1) v += __shfl_xor(v, o);
    return v;
}

__device__ __forceinline__ void p0_transpose_item(const float* W, int K, int N, bf16* WT, const float* gain, LAS float* scr, int item, int lane) {
    const int nblk = N / 32, kb = item / nblk, nb = item % nblk, k0 = 64 * kb, n0 = 32 * nb;
    f32x4 v[8];
#pragma unroll
    for (int i = 0; i < 8; ++i) v[i] = __builtin_nontemporal_load((const f32x4*)(W + (size_t)(k0 + 8 * i + (lane >> 3)) * N + n0 + 4 * (lane & 7)));
#pragma unroll
    for (int i = 0; i < 8; ++i) { const int kk = 8 * i + (lane >> 3); const float g = gain ? gain[k0 + kk] : 1.0f; LAS float* d = scr + kk * 33 + 4 * (lane & 7);
        d[0] = v[i][0] * g; d[1] = v[i][1] * g; d[2] = v[i][2] * g; d[3] = v[i][3] * g; }
    LDS_WAIT(); asm volatile("" ::: "memory");
    const int c = lane & 7;
#pragma unroll
    for (int j = 0; j < 4; ++j) { const int n = (lane >> 3) + 8 * j; const LAS float* s = scr + (8 * c) * 33 + n;
        u32x4 o; o.x = pk2(s[0 * 33], s[1 * 33]); o.y = pk2(s[2 * 33], s[3 * 33]); o.z = pk2(s[4 * 33], s[5 * 33]); o.w = pk2(s[6 * 33], s[7 * 33]);
        *(u32x4*)(WT + (size_t)(n0 + n) * K + k0 + 8 * c) = o; }
    LDS_WAIT(); asm volatile("" ::: "memory");
}
__device__ __forceinline__ void rms_row_to_bf16(const float* xrow, const float* g, bf16* orow, int lane) {
    const f32x4* xr = (const f32x4*)xrow + lane; const f32x4* gr = (const f32x4*)g + lane;
    f32x4 v[4]; float s = 0.f;
#pragma unroll
    for (int j = 0; j < 4; ++j) { v[j] = xr[64 * j]; s += (v[j][0] * v[j][0] + v[j][1] * v[j][1]) + (v[j][2] * v[j][2] + v[j][3] * v[j][3]); }
    const float rs = 1.0f / sqrtf(wave_sum(s) * (1.0f / 1024.0f) + EPS);
    u32x2* o8 = (u32x2*)orow + lane;
#pragma unroll
    for (int j = 0; j < 4; ++j) { const f32x4 gv = gr[64 * j]; u32x2 o; o.x = pk2(v[j][0] * rs * gv[0], v[j][1] * rs * gv[1]); o.y = pk2(v[j][2] * rs * gv[2], v[j][3] * rs * gv[3]); o8[64 * j] = o; }
}

struct Args { const float* in[17]; float* out; unsigned char* ws; int ph_lo, ph_hi; };
enum { I_X = 0, I_MEM, I_GMIX, I_WIN, I_CONVW, I_GATT, I_GCONV, I_WOUT, I_GX, I_GMEM, I_WQ, I_WKV, I_WO, I_GMLP, I_WUP, I_WDN, I_GFIN };

__device__ __forceinline__ void p0_rows(const Args& a, int gw, int NGW, int lane) {
    const float* X = a.in[I_X]; const float* g = a.in[I_GMIX]; bf16* H1 = (bf16*)(a.ws + WS_H1);
    const f32x4* gr = (const f32x4*)g + lane;
#pragma unroll 1
    for (int m = gw; m < MTOK; m += 2 * NGW) {
        const int m2 = m + NGW; const bool has2 = m2 < MTOK;
        const f32x4* x0 = (const f32x4*)(X + (size_t)m * 1024) + lane; const f32x4* x1 = (const f32x4*)(X + (size_t)(has2 ? m2 : m) * 1024) + lane;
        f32x4 v[4], w[4]; float s0 = 0.f, s1 = 0.f;
#pragma unroll
        for (int j = 0; j < 4; ++j) { v[j] = __builtin_nontemporal_load(x0 + 64 * j); w[j] = __builtin_nontemporal_load(x1 + 64 * j); }
#pragma unroll
        for (int j = 0; j < 4; ++j) { s0 += (v[j][0] * v[j][0] + v[j][1] * v[j][1]) + (v[j][2] * v[j][2] + v[j][3] * v[j][3]); s1 += (w[j][0] * w[j][0] + w[j][1] * w[j][1]) + (w[j][2] * w[j][2] + w[j][3] * w[j][3]); }
#pragma unroll
        for (int o = 1; o < 64; o <<= 1) { s0 += __shfl_xor(s0, o); s1 += __shfl_xor(s1, o); }
        const float r0 = 1.0f / sqrtf(s0 * (1.0f / 1024.0f) + EPS), r1 = 1.0f / sqrtf(s1 * (1.0f / 1024.0f) + EPS);
        u32x2* o0 = (u32x2*)(H1 + (size_t)m * 1024) + lane; u32x2* o1 = (u32x2*)(H1 + (size_t)m2 * 1024) + lane;
#pragma unroll
        for (int j = 0; j < 4; ++j) { const f32x4 gv = gr[64 * j]; u32x2 o; o.x = pk2(v[j][0] * r0 * gv[0], v[j][1] * r0 * gv[1]); o.y = pk2(v[j][2] * r0 * gv[2], v[j][3] * r0 * gv[3]); o0[64 * j] = o;
            if (has2) { u32x2 p; p.x = pk2(w[j][0] * r1 * gv[0], w[j][1] * r1 * gv[1]); p.y = pk2(w[j][2] * r1 * gv[2], w[j][3] * r1 * gv[3]); o1[64 * j] = p; } }
    }
}
__device__ __forceinline__ void p0_prologue(const Args& a, LAS unsigned char* lds, int gw, int NGW, int wave, int lane) {
    unsigned char* ws = a.ws;
    LAS float* scr = (LAS float*)(lds + wave * 16384);
    constexpr int I_IN = 16 * 96, I_OUT = 16 * 32, I_KV = 16 * 64, I_O = 16 * 32, I_UP = 16 * 128, I_DN = 64 * 32;
    constexpr int NITEMS = I_IN + I_OUT + I_KV + I_O + I_UP + I_DN;
    const bool rows_first = (wave & 1) != 0;
    if (rows_first) p0_rows(a, gw, NGW, lane);
    for (int it = gw; it < NITEMS; it += NGW) {
        int r = it;
        if (r < I_IN) { p0_transpose_item(a.in[I_WIN], 1024, 3072, (bf16*)(ws + WS_WIN), nullptr, scr, r, lane); continue; } r -= I_IN;
        if (r < I_OUT) { p0_transpose_item(a.in[I_WOUT], 1024, 1024, (bf16*)(ws + WS_WOUT), nullptr, scr, r, lane); continue; } r -= I_OUT;
        if (r < I_KV) { p0_transpose_item(a.in[I_WKV], 1024, 2048, (bf16*)(ws + WS_WKV), nullptr, scr, r, lane); continue; } r -= I_KV;
        if (r < I_O) { p0_transpose_item(a.in[I_WO], 1024, 1024, (bf16*)(ws + WS_WO), nullptr, scr, r, lane); continue; } r -= I_O;
        if (r < I_UP) { p0_transpose_item(a.in[I_WUP], 1024, 4096, (bf16*)(ws + WS_WUP), a.in[I_GMLP], scr, r, lane); continue; } r -= I_UP;
        p0_transpose_item(a.in[I_WDN], 4096, 1024, (bf16*)(ws + WS_WDN), nullptr, scr, r, lane);
    }
    for (int c = gw; c < 1024; c += NGW) { const float g = a.in[I_GX][c]; const f32x4* wr_ = (const f32x4*)(a.in[I_WQ] + (size_t)c * 1024) + lane; u32x2* o8 = (u32x2*)((bf16*)(ws + WS_WQS) + (size_t)c * 1024) + lane;
#pragma unroll
        for (int j = 0; j < 4; ++j) { const f32x4 v = wr_[64 * j]; u32x2 o; o.x = pk2(v[0] * g, v[1] * g); o.y = pk2(v[2] * g, v[3] * g); o8[64 * j] = o; } }
    for (int m = gw; m < MMEM; m += NGW) rms_row_to_bf16(a.in[I_MEM] + (size_t)m * 1024, a.in[I_GMEM], (bf16*)(ws + WS_MEMN) + (size_t)m * 1024, lane);
    if (!rows_first) p0_rows(a, gw, NGW, lane);
}

__device__ __forceinline__ void unpack8(const u32x4 w, float (&f)[8]) {
#pragma unroll
    for (int i = 0; i < 4; ++i) { f[2 * i] = __uint_as_float(w[i] << 16); f[2 * i + 1] = __uint_as_float(w[i] & 0xffff0000u); }
}
typedef float f32x16 __attribute__((ext_vector_type(16)));
typedef short bf16x8 __attribute__((ext_vector_type(8)));
typedef short s16x4 __attribute__((ext_vector_type(4)));
__device__ __forceinline__ float swap32_max(float v) { auto rr = __builtin_amdgcn_permlane32_swap(__float_as_uint(v), __float_as_uint(v), false, false); return fmaxf(__uint_as_float(rr[0]), __uint_as_float(rr[1])); }
__device__ __forceinline__ float swap32_sum(float v) { auto rr = __builtin_amdgcn_permlane32_swap(__float_as_uint(v), __float_as_uint(v), false, false); return __uint_as_float(rr[0]) + __uint_as_float(rr[1]); }
__device__ __forceinline__ s16x4 vtr(const LAS unsigned char* p) { return __builtin_bit_cast(s16x4, __builtin_amdgcn_ds_read_tr16_b64_v4i16((LAS s16x4*)p)); }
__device__ __forceinline__ bf16x8 packp(const f32x16& p, int b) { u32x4 w; w.x = pg8::cvt_pk_bf16(p[b], p[b + 1]); w.y = pg8::cvt_pk_bf16(p[b + 2], p[b + 3]); w.z = pg8::cvt_pk_bf16(p[b + 4], p[b + 5]); w.w = pg8::cvt_pk_bf16(p[b + 6], p[b + 7]); return __builtin_bit_cast(bf16x8, w); }

constexpr int P2_UNITS = 3072, P2_KIMG = 0, P2_VIMG = 49152, P2_STAGE = 98304;
struct P2Unit { const bf16* pb; int h, p, dil, r, m0; size_t tokbase; };
__device__ __forceinline__ P2Unit p2_decode(int L, const bf16* proj) {
    P2Unit u; const int xcd = L & 7, idx = L >> 3, b = idx / 48, rem = idx % 48, uu = rem & 15; u.p = rem >> 4; u.h = xcd;
    const int dsh = 2 * u.p; u.dil = 1 << dsh; const int chunk = uu & ((16 >> dsh) - 1); u.r = uu >> (4 - dsh); u.m0 = chunk * 256;
    u.pb = proj + (size_t)(b * 8 + u.h) * SEQ * 64; u.tokbase = (size_t)b * SEQ; return u;
}
constexpr size_t QKV_PLANE = (size_t)MTOK * AW;
__device__ __forceinline__ void p2a_attn(const bf16* proj, bf16* op01, bf16* op2, float* lse, LAS unsigned char* lds, int G, int bx, int wave, int tid) {
    const int lane = tid & 63, r32 = lane & 31, hi = lane >> 5;
    const int vr_off = (4 * hi + ((lane & 15) >> 2)) * 64 + ((lane >> 4) & 1) * 32 + (lane & 3) * 8;
    u32x4 kreg[6], vreg[6], qn[4];
    LAS unsigned char* stage = lds + P2_STAGE + wave * 4096;
#define P2A_ISSUE(LL) do { const P2Unit un = p2_decode((LL), proj); \
        _Pragma("unroll") for (int j = 0; j < 4; ++j) { const int row = (lane >> 3) + 8 * j; \
          qn[j] = *(const u32x4*)(un.pb + (size_t)((un.m0 + 32 * wave + row) * un.dil + un.r) * 64 + (lane & 7) * 8); } \
        _Pragma("unroll") for (int j = 0; j < 6; ++j) { const int q = tid + 512 * j, row = q >> 3, ch = q & 7; const int pos = max(un.m0 - 128 + row, 0); \
          const bf16* kp = un.pb + QKV_PLANE + (size_t)(pos * un.dil + un.r) * 64 + ch * 8; kreg[j] = *(const u32x4*)kp; vreg[j] = *(const u32x4*)(kp + QKV_PLANE); } } while (0)
    const int xcd_ = bx & 7, cl = bx >> 3;
    const bool g256 = (G == 256);
    const int ncl = g256 ? 32 : (G + 7 - xcd_) / 8;
    const int cnt = g256 ? (cl < 8 ? 9 : 13) : (384 - cl + ncl - 1) / ncl;
#define P2A_IDX(k) ((g256 && (k) >= 9) ? 288 + 24 * ((k) - 9) + (cl - 8) : ncl * (k) + cl)
    if (cnt > 0) P2A_ISSUE(P2A_IDX(0) * 8 + xcd_);
#pragma unroll 1
    for (int k = 0; k < cnt; ++k) {
        const int L = P2A_IDX(k) * 8 + xcd_;
        const P2Unit u = p2_decode(L, proj);
        __syncthreads();
#pragma unroll
        for (int j = 0; j < 6; ++j) { const int q = tid + 512 * j, row = q >> 3, ch = q & 7;
            *(LAS u32x4*)(lds + P2_KIMG + row * 128 + ((ch ^ (row & 7)) * 16)) = kreg[j];
            *(LAS u32x4*)(lds + P2_VIMG + (row >> 5) * 4096 + (ch >> 2) * 2048 + (row & 31) * 64 + (ch & 3) * 16) = vreg[j]; }
#pragma unroll
        for (int j = 0; j < 4; ++j) { const int row = (lane >> 3) + 8 * j; *(LAS u32x4*)(stage + row * 128 + (((lane & 7) ^ (row & 7)) * 16)) = qn[j]; }
        asm volatile("" ::: "memory");
        bf16x8 qf[4];
#pragma unroll
        for (int d0 = 0; d0 < 4; ++d0) qf[d0] = *(const LAS bf16x8*)(stage + r32 * 128 + (((2 * d0 + hi) ^ (r32 & 7)) * 16));
        __syncthreads();
        if (k + 1 < cnt) P2A_ISSUE(P2A_IDX(k + 1) * 8 + xcd_);
        f32x16 pt[5];
#pragma unroll
        for (int j = 0; j < 5; ++j) {
            const int kt = wave + j;
            if (u.m0 - 128 + 32 * kt >= 0) {
                const LAS unsigned char* kb = lds + P2_KIMG + kt * 4096 + r32 * 128;
#pragma unroll
                for (int i = 0; i < 16; ++i) pt[j][i] = 0.f;
                bf16x8 kf[4];
#pragma unroll
                for (int d0 = 0; d0 < 4; ++d0) kf[d0] = *(const LAS bf16x8*)(kb + (((2 * d0 + hi) ^ (r32 & 7)) * 16));
#pragma unroll
                for (int d0 = 0; d0 < 4; ++d0) pt[j] = __builtin_amdgcn_mfma_f32_32x32x16_bf16(kf[d0], qf[d0], pt[j], 0, 0, 0);
            } else {
#pragma unroll
                for (int i = 0; i < 16; ++i) pt[j][i] = -1.0e30f;
            }
        }
#pragma unroll
        for (int i = 0; i < 16; ++i) { const int kk = (i & 3) + 8 * (i >> 2) + 4 * hi;
            pt[0][i] = (kk >= r32) ? pt[0][i] : -1.0e30f;
            pt[4][i] = (kk <= r32) ? pt[4][i] : -1.0e30f; }
        float mxa = fmaxf(pt[0][0], pt[1][0]), mxb = fmaxf(pt[2][0], pt[3][0]), mxc = pt[4][0];
#pragma unroll
        for (int i = 1; i < 16; ++i) { mxa = fmaxf(mxa, fmaxf(pt[0][i], pt[1][i])); mxb = fmaxf(mxb, fmaxf(pt[2][i], pt[3][i])); mxc = fmaxf(mxc, pt[4][i]); }
        const float m_run = swap32_max(fmaxf(fmaxf(mxa, mxb), mxc));
        float la = 0.f, lb = 0.f;
#pragma unroll
        for (int j = 0; j < 5; ++j)
#pragma unroll
            for (int i = 0; i < 16; i += 2) { pt[j][i] = __builtin_amdgcn_exp2f(pt[j][i] - m_run); pt[j][i + 1] = __builtin_amdgcn_exp2f(pt[j][i + 1] - m_run); la += pt[j][i]; lb += pt[j][i + 1]; }
        float l = la + lb;
        f32x16 o0, o1;
#pragma unroll
        for (int i = 0; i < 16; ++i) { o0[i] = 0.f; o1[i] = 0.f; }
#pragma unroll
        for (int j = 0; j < 5; ++j) {
            const int kt = wave + j;
            if (u.m0 - 128 + 32 * kt >= 0) {
                const bf16x8 pf0 = packp(pt[j], 0), pf1 = packp(pt[j], 8);
                const LAS unsigned char* vb = lds + P2_VIMG + kt * 4096 + vr_off;
#pragma unroll
                for (int ks = 0; ks < 2; ++ks) {
                    const s16x4 a0 = vtr(vb + ks * 1024), a1 = vtr(vb + ks * 1024 + 512), b0 = vtr(vb + 2048 + ks * 1024), b1 = vtr(vb + 2048 + ks * 1024 + 512);
                    const bf16x8 v0 = {a0[0], a0[1], a0[2], a0[3], a1[0], a1[1], a1[2], a1[3]}, v1 = {b0[0], b0[1], b0[2], b0[3], b1[0], b1[1], b1[2], b1[3]};
                    o0 = __builtin_amdgcn_mfma_f32_32x32x16_bf16(v0, ks ? pf1 : pf0, o0, 0, 0, 0);
                    o1 = __builtin_amdgcn_mfma_f32_32x32x16_bf16(v1, ks ? pf1 : pf0, o1, 0, 0, 0);
                }
            }
        }
        l = swap32_sum(l);
        const float inv = 1.0f / l;
        const size_t token = u.tokbase + (size_t)(u.m0 + 32 * wave + r32) * u.dil + u.r;
        bf16* obase = (u.p == 2 ? op2 : op01 + (size_t)u.p * MTOK * AW) + u.h * 64 + (lane & 7) * 8;
#pragma unroll
        for (int g4 = 0; g4 < 4; ++g4) {
            u32x2 wa, wb;
            wa.x = pg8::cvt_pk_bf16(o0[4 * g4] * inv, o0[4 * g4 + 1] * inv); wa.y = pg8::cvt_pk_bf16(o0[4 * g4 + 2] * inv, o0[4 * g4 + 3] * inv);
            wb.x = pg8::cvt_pk_bf16(o1[4 * g4] * inv, o1[4 * g4 + 1] * inv); wb.y = pg8::cvt_pk_bf16(o1[4 * g4 + 2] * inv, o1[4 * g4 + 3] * inv);
            *(LAS u32x2*)(stage + r32 * 128 + ((g4 ^ (r32 & 7)) * 16) + 8 * hi) = wa;
            *(LAS u32x2*)(stage + r32 * 128 + (((4 + g4) ^ (r32 & 7)) * 16) + 8 * hi) = wb;
        }
        asm volatile("" ::: "memory");
#pragma unroll
        for (int j = 0; j < 4; ++j) { const int row = (lane >> 3) + 8 * j;
            const u32x4 v = *(const LAS u32x4*)(stage + row * 128 + (((lane & 7) ^ (row & 7)) * 16));
            *(u32x4*)(obase + (u.tokbase + (size_t)(u.m0 + 32 * wave + row) * u.dil + u.r) * AW) = v; }
        if (hi == 0) lse[((size_t)u.p * MTOK + token) * 8 + u.h] = m_run + __builtin_amdgcn_logf(l);
    }
#undef P2A_ISSUE
#undef P2A_IDX
}
struct P3Tok { float l0, l1, l2; u32x4 a0, a1, a2, bg, cg0, xc0, cg1, xc1, cg2, xc2; };
__device__ __forceinline__ void p3_load(P3Tok& k, const bf16* proj, const bf16* op01, const bf16* op2, const float* lse, int token, int lane) {
    const int hh = lane >> 3, c0 = 8 * lane, t = token & (SEQ - 1); const bf16* prow = proj + (size_t)token * CONVP; const u32x4 z = {0u, 0u, 0u, 0u};
    k.l0 = __builtin_nontemporal_load(lse + (size_t)token * 8 + hh); k.l1 = __builtin_nontemporal_load(lse + ((size_t)MTOK + token) * 8 + hh); k.l2 = __builtin_nontemporal_load(lse + ((size_t)2 * MTOK + token) * 8 + hh);
    k.a0 = __builtin_nontemporal_load((const u32x4*)(op01 + (size_t)token * AW + c0)); k.a1 = __builtin_nontemporal_load((const u32x4*)(op01 + ((size_t)MTOK + token) * AW + c0)); k.a2 = __builtin_nontemporal_load((const u32x4*)(op2 + (size_t)token * AW + c0));
    k.bg = *(const u32x4*)(prow + c0); k.cg0 = *(const u32x4*)(prow + 512 + c0); k.xc0 = *(const u32x4*)(prow + 1024 + c0);
    k.cg1 = t >= 1 ? *(const u32x4*)(prow - CONVP + 512 + c0) : z; k.xc1 = t >= 1 ? *(const u32x4*)(prow - CONVP + 1024 + c0) : z;
    k.cg2 = t >= 2 ? *(const u32x4*)(prow - 2 * CONVP + 512 + c0) : z; k.xc2 = t >= 2 ? *(const u32x4*)(prow - 2 * CONVP + 1024 + c0) : z;
}
__device__ __forceinline__ void p3_compute(const P3Tok& k, const float* conv_w, const float* g_a, const float* g_c, bf16* merged, int token, int lane) {
    const int c0 = 8 * lane;
    const float mx = fmaxf(k.l0, fmaxf(k.l1, k.l2));
    float w0 = __builtin_amdgcn_exp2f(k.l0 - mx), w1 = __builtin_amdgcn_exp2f(k.l1 - mx), w2 = __builtin_amdgcn_exp2f(k.l2 - mx);
    const float winv = 1.0f / (w0 + w1 + w2); w0 *= winv; w1 *= winv; w2 *= winv;
    float a0[8], a1[8], a2[8], bg[8], cg0[8], xc0[8], cg1[8], xc1[8], cg2[8], xc2[8];
    unpack8(k.a0, a0); unpack8(k.a1, a1); unpack8(k.a2, a2); unpack8(k.bg, bg); unpack8(k.cg0, cg0); unpack8(k.xc0, xc0); unpack8(k.cg1, cg1); unpack8(k.xc1, xc1); unpack8(k.cg2, cg2); unpack8(k.xc2, xc2);
    float y[8], yc[8]; float ss = 0.f, sc = 0.f;
#pragma unroll
    for (int e = 0; e < 8; ++e) { y[e] = w0 * a0[e] + w1 * a1[e] + w2 * a2[e]; ss += y[e] * y[e];
        const float cw0 = conv_w[c0 + e], cw1 = conv_w[512 + c0 + e], cw2 = conv_w[1024 + c0 + e];
        yc[e] = bg[e] * (cw0 * (cg2[e] * xc2[e]) + cw1 * (cg1[e] * xc1[e]) + cw2 * (cg0[e] * xc0[e])); sc += yc[e] * yc[e]; }
#pragma unroll
    for (int o = 1; o < 64; o <<= 1) { ss += __shfl_xor(ss, o); sc += __shfl_xor(sc, o); }
    const float rs = 1.0f / sqrtf(ss * (1.0f / 512.0f) + EPS), rc = 1.0f / sqrtf(sc * (1.0f / 512.0f) + EPS);
    u32x4 o, oc;
#pragma unroll
    for (int i = 0; i < 4; ++i) { o[i] = pk2(y[2 * i] * rs * g_a[c0 + 2 * i], y[2 * i + 1] * rs * g_a[c0 + 2 * i + 1]); oc[i] = pk2(yc[2 * i] * rc * g_c[c0 + 2 * i], yc[2 * i + 1] * rc * g_c[c0 + 2 * i + 1]); }
    *(u32x4*)(merged + (size_t)token * 1024 + c0) = o; *(u32x4*)(merged + (size_t)token * 1024 + 512 + c0) = oc;
}
__device__ __forceinline__ void p3_merge(const bf16* proj, const bf16* op01, const bf16* op2, const float* lse, const float* conv_w, const float* g_a, const float* g_c, bf16* merged, int gw, int NGW, int lane) {
#pragma unroll 1
    for (int token = gw; token < MTOK; token += 2 * NGW) {
        const int tok2 = token + NGW; const bool has2 = tok2 < MTOK;
        P3Tok k0, k1;
        p3_load(k0, proj, op01, op2, lse, token, lane); p3_load(k1, proj, op01, op2, lse, has2 ? tok2 : token, lane);
        p3_compute(k0, conv_w, g_a, g_c, merged, token, lane);
        if (has2) p3_compute(k1, conv_w, g_a, g_c, merged, tok2, lane);
    }
}
__device__ __forceinline__ void p8_final(float* out, const float* g, int gw, int NGW, int lane) {
    for (int m = gw; m < MTOK; m += NGW) {
        f32x4* xr = (f32x4*)(out + (size_t)m * 1024) + lane; const f32x4* gr = (const f32x4*)g + lane;
        f32x4 v[4]; float s = 0.f;
#pragma unroll
        for (int j = 0; j < 4; ++j) { v[j] = xr[64 * j]; s += (v[j][0] * v[j][0] + v[j][1] * v[j][1]) + (v[j][2] * v[j][2] + v[j][3] * v[j][3]); }
        const float rs = 1.0f / sqrtf(wave_sum(s) * (1.0f / 1024.0f) + EPS);
#pragma unroll
        for (int j = 0; j < 4; ++j) xr[64 * j] = v[j] * rs * gr[64 * j];
    }
}

#define RLX_AGENT __ATOMIC_RELAXED, __HIP_MEMORY_SCOPE_AGENT
#define XB_TMO      128
#define XB_XCNT(j)  (256  + 64 * (j))
#define XB_XSUB(j)  (1280 + 64 * (j))
#define XB_XGEN(j)  (2304 + 64 * (j))
#define XB_TOP      3328
#define XB_TOPGEN   3392
#define XCD_BAR_WORDS 3456
#define XB_SPIN_CAP (1u << 18)

__device__ __forceinline__ unsigned xb_ld(unsigned* p)              { return __hip_atomic_load(p, __ATOMIC_RELAXED, __HIP_MEMORY_SCOPE_AGENT); }
__device__ __forceinline__ unsigned xb_add(unsigned* p, unsigned v) { return __hip_atomic_fetch_add(p, v, __ATOMIC_RELAXED, __HIP_MEMORY_SCOPE_AGENT); }
__device__ __forceinline__ unsigned xb_xcc_id() { return (unsigned)__builtin_amdgcn_s_getreg((3 << 11) | 20) & 0xFu; }
#define XB_SPIN(cond, bar) do { unsigned _sp = 0; while (cond) { __builtin_amdgcn_s_sleep(1); \
    if ((++_sp & 255u) == 0u) { if (xb_ld(&(bar)[XB_TMO])) break; if (_sp > XB_SPIN_CAP) { atomicAdd(&(bar)[XB_TMO], 1u); break; } } } } while (0)

struct XcdBarrier {
    unsigned* bar; unsigned x;
    volatile LAS unsigned* st;
};

__device__ __forceinline__ XcdBarrier xcd_barrier_post(unsigned* bar, volatile LAS unsigned* st) {
    XcdBarrier b; b.bar = bar; b.x = xb_xcc_id(); b.st = st;
    if (threadIdx.x == 0) (void)xb_add(&bar[XB_XCNT(b.x)], 1u);
    return b;
}
__device__ __forceinline__ void xcd_barrier_complete(unsigned* bar, unsigned x, unsigned& nloc, unsigned& nx) {
    const unsigned G = gridDim.x * gridDim.y * gridDim.z;
    unsigned sum, cnt, mine, sp = 0u;
    for (;;) {
        sum = 0u; cnt = 0u; mine = 0u;
#pragma unroll
        for (unsigned j = 0; j < 16; ++j) { const unsigned c = xb_ld(&bar[XB_XCNT(j)]); sum += c; cnt += (c > 0u) ? 1u : 0u; mine = (j == x) ? c : mine; }
        if (sum == G) break;
        __builtin_amdgcn_s_sleep(1);
        if ((++sp & 255u) == 0u) { if (xb_ld(&bar[XB_TMO])) break; if (sp > XB_SPIN_CAP) { atomicAdd(&bar[XB_TMO], 1u); break; } }
    }
    nloc = mine > 0u ? mine : 1u; nx = cnt > 0u ? cnt : 1u;
}

__device__ __forceinline__ void xcd_barrier(const XcdBarrier& b) {
    asm volatile("s_waitcnt vmcnt(0)" ::: "memory");
    __syncthreads();
    if (threadIdx.x == 0) {
        unsigned* bar = b.bar;
        __builtin_amdgcn_s_waitcnt(0);
        unsigned nloc = b.st[0], nx = b.st[1];
        if (nloc == 0u) { xcd_barrier_complete(bar, b.x, nloc, nx); b.st[0] = nloc; b.st[1] = nx; }
        const unsigned old = xb_add(&bar[XB_XSUB(b.x)], 1u);
        const unsigned gen = old / nloc;
        if (old + 1u == (gen + 1u) * nloc) {
            __builtin_amdgcn_fence(__ATOMIC_RELEASE, "agent");
            asm volatile("s_waitcnt vmcnt(0)" ::: "memory");
            const unsigned og = xb_add(&bar[XB_TOP], 1u);
            const unsigned tg = og / nx;
            if (og + 1u == (tg + 1u) * nx) xb_add(&bar[XB_TOPGEN], 1u);
            else XB_SPIN(xb_ld(&bar[XB_TOPGEN]) == tg, bar);
            __builtin_amdgcn_fence(__ATOMIC_ACQUIRE, "agent");
            xb_add(&bar[XB_XGEN(b.x)], 1u);
            asm volatile("s_waitcnt vmcnt(0)" ::: "memory");
        } else {
            XB_SPIN(xb_ld(&bar[XB_XGEN(b.x)]) == gen, bar);
            __builtin_amdgcn_fence(__ATOMIC_ACQUIRE, "agent");
            asm volatile("s_waitcnt vmcnt(0)" ::: "memory");
        }
    }
    __syncthreads();
}
constexpr int NPHASE = 10;
constexpr int CW_PANEL = 4096;
#ifndef DUP_PHASE
#define DUP_PHASE -1
#endif
#define NREP(k) ((k) == DUP_PHASE ? 2 : 1)
__global__ void __launch_bounds__(NWAVES * 64, 2) mega(Args a) {
    extern __shared__ __attribute__((aligned(16))) unsigned char lds_raw[];
    LAS unsigned char* lds = (LAS unsigned char*)lds_raw;
    const int wave = __builtin_amdgcn_readfirstlane((int)threadIdx.x >> 6);
#define LANE() ({ int t_ = threadIdx.x; asm volatile("" : "+v"(t_)); t_ & 63; })
    const int G = gridDim.x, bx = blockIdx.x;
    const int gw = bx * NWAVES + wave, NGW = G * NWAVES;
    unsigned char* ws = a.ws;
    const int lo = a.ph_lo, hi = a.ph_hi;
    if (lo < 0) cg::this_grid().sync();
    volatile LAS unsigned* MISC = (volatile LAS unsigned*)(lds + XCH_OFF + 8192);
    if (threadIdx.x < 64) MISC[threadIdx.x] = 0u;
    __syncthreads();
    XcdBarrier bar; bar.bar = (unsigned*)ws; bar.x = 0; bar.st = nullptr;
    if (hi - lo > 1) bar = xcd_barrier_post((unsigned*)ws, MISC + 8);
#define IN(k) (lo <= (k) && (k) < hi)
#define SEAM(k) do { if (IN(k) && IN((k) + 1)) xcd_barrier(bar); } while (0)
    bf16* const H1 = (bf16*)(ws + WS_H1); bf16* const PROJ = (bf16*)(ws + WS_PROJ); bf16* const MRG = (bf16*)(ws + WS_MRG); bf16* const HID = (bf16*)(ws + WS_HID);
    bf16* const KV = (bf16*)(ws + WS_KV); bf16* const MT = (bf16*)(ws + WS_MT); bf16* const NT = (bf16*)(ws + WS_NT);
    float* const SS1 = (float*)(ws + WS_SS1); float* const SS2 = (float*)(ws + WS_SS2);

    enum { PH_PRO = 0, PH_PROJ, PH_ATTN, PH_MERGE, PH_WOUT, PH_S, PH_PN, PH_UP, PH_DOWN, PH_FINAL };
    bf16* const QKVH = (bf16*)(ws + WS_QKV); bf16* const OP01 = (bf16*)(ws + WS_OP01); bf16* const OP2 = (bf16*)(ws + WS_OP2); float* const LSE = (float*)(ws + WS_LSE);
    if (IN(PH_PRO)) for (int rep = 0; rep < NREP(PH_PRO); ++rep) { p0_prologue(a, lds, gw, NGW, wave, LANE()); __syncthreads(); }
    SEAM(PH_PRO);
    if (IN(PH_PROJ)) for (int rep = 0; rep < NREP(PH_PROJ); ++rep) {
        { pg8::Gemm g{1024, 1024, 1024}; SchedStd S; S.init(H1, 1024, ws + WS_WIN, 1024, MTOK, INC, G, bx); pg8::EpiProj E{PROJ, QKVH, 0.125f * LOG2E};
          pg8::gemm_phase<pg8::EpiProj, SchedStd, true, true>(lds, g, S, E); }
    }
    SEAM(PH_PROJ);
    if (IN(PH_ATTN)) for (int rep = 0; rep < NREP(PH_ATTN); ++rep) {
        { pg8::Gemm g{1024, 1024, 1024}; SchedStd S; S.init(ws + WS_MEMN, 1024, ws + WS_WKV, 1024, MMEM, 2048, G, bx); pg8::EpiStore E{KV, 2048, 0, 1.0f};
          pg8::gemm_phase<pg8::EpiStore, SchedStd, true, true>(lds, g, S, E); }
        { int t_ = threadIdx.x; asm volatile("" : "+v"(t_)); p2a_attn(QKVH, OP01, OP2, LSE, lds, G, bx, wave, t_); }
    }
    SEAM(PH_ATTN);
    if (IN(PH_MERGE)) for (int rep = 0; rep < NREP(PH_MERGE); ++rep) {
        int k256 = 256; asm volatile("" : "+s"(k256));
        { pg8::Gemm g{k256, 2048, 1024}; SchedMt S{G, bx, (const char*)KV, (const char*)(ws + WS_WQS)}; pg8::EpiStore E{MT, 1024, 0, 1.0f};
          pg8::gemm_phase<pg8::EpiStore, SchedMt, true, true>(lds, g, S, E); }
        { pg8::Gemm g{k256, 1024, 2048}; SchedNt S{G, bx, (const char*)KV, (const char*)(ws + WS_WO)}; pg8::EpiStore E{NT, 1024, 0, 1.0f};
          pg8::gemm_phase<pg8::EpiStore, SchedNt, true, true>(lds, g, S, E); }
        p3_merge(PROJ, OP01, OP2, LSE, a.in[I_CONVW], a.in[I_GATT], a.in[I_GCONV], MRG, gw, NGW, LANE());
    }
    SEAM(PH_MERGE);
    if (IN(PH_WOUT)) for (int rep = 0; rep < NREP(PH_WOUT); ++rep) { pg8::Gemm g{1024, 1024, 1024}; SchedStd S; S.init(MRG, 1024, ws + WS_WOUT, 1024, MTOK, 1024, G, bx); pg8::EpiResid<false> E{a.in[I_X], nullptr, H1, SS1};
        pg8::gemm_phase<pg8::EpiResid<false>, SchedStd, false, true>(lds, g, S, E); }
    SEAM(PH_WOUT);
    if (IN(PH_S)) for (int rep = 0; rep < NREP(PH_S); ++rep) { pg8::Gemm g{1024, 1024, 1024}; SchedStd S; S.init(H1, 1024, MT, 1024, MTOK, 1024, G, bx, 4, (size_t)1024 * 1024 * 2); pg8::EpiSoftmax E{SS1, PROJ, (LAS float*)(lds + XCH_OFF)};
        pg8::gemm_phase<pg8::EpiSoftmax, SchedStd, true, true>(lds, g, S, E); }
    SEAM(PH_S);
    if (IN(PH_PN)) for (int rep = 0; rep < NREP(PH_PN); ++rep) { pg8::Gemm g{1024, 1024, 1024}; SchedStd S; S.init(PROJ, 1024, NT, 1024, MTOK, 1024, G, bx, 4, (size_t)1024 * 1024 * 2); pg8::EpiResid<true> E{H1, nullptr, MRG, SS2};
        pg8::gemm_phase<pg8::EpiResid<true>, SchedStd, true, true>(lds, g, S, E); }
    SEAM(PH_PN);
    if (IN(PH_UP)) for (int rep = 0; rep < NREP(PH_UP); ++rep) { pg8::Gemm g{1024, 1024, 1024}; SchedStd S; S.init(MRG, 1024, ws + WS_WUP, 1024, MTOK, FF, G, bx); pg8::EpiRelu2 E{SS2, HID, HIDP};
        pg8::gemm_phase<pg8::EpiRelu2, SchedStd, true, true>(lds, g, S, E); }
    SEAM(PH_UP);
    const bool fuse_final = (G == 256) && IN(PH_DOWN) && IN(PH_FINAL);
    if (IN(PH_DOWN)) for (int rep = 0; rep < NREP(PH_DOWN); ++rep) { pg8::Gemm g{4096, HIDP, 4096}; SchedStd S; S.init(HID, HIDP, ws + WS_WDN, 4096, MTOK, 1024, G, bx);
        if (fuse_final) { pg8::EpiFinal E{MRG, a.out, a.in[I_GFIN], (unsigned*)(ws + WS_SS1), (unsigned*)ws + CW_PANEL, (LAS float*)(lds + XCH_OFF)};
            pg8::gemm_phase<pg8::EpiFinal, SchedStd, true, true>(lds, g, S, E); }
        else { pg8::EpiResid<true> E{MRG, a.out, nullptr, nullptr};
            pg8::gemm_phase<pg8::EpiResid<true>, SchedStd, true, true>(lds, g, S, E); } }
    if (!fuse_final) {
        SEAM(PH_DOWN);
        if (IN(PH_FINAL)) p8_final(a.out, a.in[I_GFIN], gw, NGW, LANE());
    }
#undef IN
#undef SEAM
}

extern "C" void kernel_launch(void* const* d_in, const int* in_sizes, int n_in, void* d_out, int out_size, void* d_ws, size_t ws_size, hipStream_t stream) {
    static int grid = 0;
    if (grid == 0) {
        if (n_in != 17 || in_sizes[0] != MTOK * DM || out_size != MTOK * DM || ws_size < WS_END) { fprintf(stderr, "kernel_launch: unexpected shapes (n_in %d, in0 %d, out %d, ws %zu); nothing launched\n", n_in, n_in > 0 ? in_sizes[0] : -1, out_size, ws_size); grid = -1; return; }
        int dev = 0, cus = 0, per_cu = 0;
        if (hipGetDevice(&dev) != hipSuccess || hipDeviceGetAttribute(&cus, hipDeviceAttributeMultiprocessorCount, dev) != hipSuccess) { grid = -1; return; }
        if (hipFuncSetAttribute((const void*)mega, hipFuncAttributeMaxDynamicSharedMemorySize, LDS_BYTES) != hipSuccess) { fprintf(stderr, "kernel_launch: hipFuncSetAttribute failed\n"); grid = -1; return; }
        if (hipOccupancyMaxActiveBlocksPerMultiprocessor(&per_cu, (const void*)mega, NWAVES * 64, LDS_BYTES) != hipSuccess || per_cu < 1) { fprintf(stderr, "kernel_launch: occupancy query says %d\n", per_cu); per_cu = 1; }
        (void)hipGetLastError();
        grid = cus * per_cu;
    }
    if (grid < 0) return;
    Args a{};
    for (int i = 0; i < 17; ++i) a.in[i] = (const float*)d_in[i];
    a.out = (float*)d_out; a.ws = (unsigned char*)d_ws;
#if N_LAUNCHES == 1
    if (hipMemsetAsync(d_ws, 0, 65536, stream) != hipSuccess) { fprintf(stderr, "kernel_launch: hipMemsetAsync failed\n"); return; }
    a.ph_lo = 0; a.ph_hi = NPHASE;
    void* args[] = {&a};
    hipError_t e = hipLaunchCooperativeKernel((const void*)mega, dim3(grid), dim3(NWAVES * 64), args, LDS_BYTES, stream);
    if (e != hipSuccess) fprintf(stderr, "kernel_launch: cooperative launch failed: %s (grid %d)\n", hipGetErrorString(e), grid);
#else
    for (int li = 0; li < NPHASE; ++li) { a.ph_lo = li; a.ph_hi = li + 1; hipLaunchKernelGGL(mega, dim3(grid), dim3(NWAVES * 64), LDS_BYTES, stream, a); }
#endif
}
```
